# Optimizing an MI355X kernel written in HIP

```python
import math
import jax
import jax.numpy as jnp
from jax import lax
import numpy as np

D_MODEL = 2048
BATCH = 4
SEQ = 4096
DEPTH = 2

N_HEADS = 8
HEAD_DIM = 128
KV_HEADS = 2
HEADS_PER_GROUP = N_HEADS // KV_HEADS
NSA_WIDTH = N_HEADS * HEAD_DIM
KV_WIDTH = KV_HEADS * HEAD_DIM
N_NSA_BRANCHES = 3
CMP_BLOCK = 32
CMP_STRIDE = 16
CMP_HIDDEN = 512
SEL_BLOCK = 64
SEL_TOPN = 16
SEL_QBLOCK = 64
WINDOW = 512
WIN_QBLOCK = 128
CONF_WIDTH = 1024
CONF_CONV_WIDTH = 31
SC_WIDTH = 1024
SC_CONV_WIDTH = 3
N_BRANCHES = 3
MIX_WIDTH = NSA_WIDTH + CONF_WIDTH + SC_WIDTH
IN_SPLITS = (NSA_WIDTH, KV_WIDTH, KV_WIDTH, KV_WIDTH, KV_WIDTH, KV_WIDTH, KV_WIDTH,
             N_HEADS * N_NSA_BRANCHES, 2 * CONF_WIDTH, 3 * SC_WIDTH, N_BRANCHES * D_MODEL)
IN_WIDTH = NSA_WIDTH + 6 * KV_WIDTH + N_HEADS * N_NSA_BRANCHES + 2 * CONF_WIDTH + 3 * SC_WIDTH + N_BRANCHES * D_MODEL
REL_BUCKETS = 32
REL_MAX_DIST = 128
N_GROUPS = 4
EXPERTS_PER_GROUP = 8
N_EXPERTS = N_GROUPS * EXPERTS_PER_GROUP
TOPK_IN_GROUP = 2
D_EXPERT = 512
PLE_DIM = 256

EPS = 1e-6
NEG_INF = -1e30
FORCE_SCORE = 1e9

kernel_name = "hybrid_nsa_conformer_shortconv_hiermoe"


def rms_norm(x, g):
    xf = x.astype(jnp.float32)
    var = jnp.mean(xf * xf, axis=-1, keepdims=True)
    return (xf * lax.rsqrt(var + EPS) * g.astype(jnp.float32)).astype(x.dtype)


def layer_norm(x, g, b):
    xf = x.astype(jnp.float32)
    mu = jnp.mean(xf, axis=-1, keepdims=True)
    var = jnp.mean(jnp.square(xf - mu), axis=-1, keepdims=True)
    y = (xf - mu) * lax.rsqrt(var + EPS) * g.astype(jnp.float32) + b.astype(jnp.float32)
    return y.astype(x.dtype)


def split_cols(z, sizes):
    cuts = [int(c) for c in np.cumsum(sizes)[:-1]]
    return jnp.split(z, cuts, axis=-1)


def causal_depthwise_conv(x, w):
    width, ch = w.shape
    return lax.conv_general_dilated(
        x, w[:, None, :].astype(x.dtype), window_strides=(1,), padding=[(width - 1, 0)],
        dimension_numbers=("NWC", "WIO", "NWC"), feature_group_count=ch)


def t5_bucket(dist):
    n = jnp.maximum(dist, 0)
    max_exact = REL_BUCKETS // 2
    nf = jnp.maximum(n, 1).astype(jnp.float32)
    large = max_exact + (jnp.log(nf / max_exact) / math.log(REL_MAX_DIST / max_exact)
                         * (REL_BUCKETS - max_exact)).astype(jnp.int32)
    large = jnp.minimum(large, REL_BUCKETS - 1)
    return jnp.where(n < max_exact, n, large)


def to_q_heads(q):
    b, s, _ = q.shape
    return q.reshape(b, s, KV_HEADS, HEADS_PER_GROUP, HEAD_DIM).transpose(0, 2, 3, 1, 4)


def to_kv_heads(k):
    b, s, _ = k.shape
    return k.reshape(b, s, KV_HEADS, HEAD_DIM).transpose(0, 2, 1, 3)


def compress_blocks(blocks, pe, w1, w2):
    b, g, nc, l, hd = blocks.shape
    flat = (blocks + pe.astype(blocks.dtype)).reshape(b, g, nc, l * hd)
    return jax.nn.gelu(flat @ w1) @ w2


def compressed_branch(q, k_cmp, v_cmp, rel_tab, scale):
    s = q.shape[3]
    n_cmp = k_cmp.shape[2]
    t = jnp.arange(s)
    blk_end = jnp.arange(n_cmp) * CMP_STRIDE + CMP_BLOCK - 1
    dist = t[:, None] - blk_end[None, :]
    valid = dist >= 0
    bias = jnp.transpose(rel_tab[t5_bucket(dist)], (2, 3, 0, 1))
    logits = jnp.einsum("bghsd,bgcd->bghsc", q, k_cmp,
                        preferred_element_type=jnp.float32) * scale + bias
    logits = jnp.where(valid, logits, NEG_INF)
    p_cmp = jnp.where(valid, jax.nn.softmax(logits, axis=-1), 0.0)
    o = jnp.einsum("bghsc,bgcd->bghsd", p_cmp.astype(v_cmp.dtype), v_cmp)
    return o, p_cmp


def select_blocks(p_cmp, s):
    n_cmp = p_cmp.shape[-1]
    n_sel_blocks = s // SEL_BLOCK
    c_start = jnp.arange(n_cmp)[:, None] * CMP_STRIDE
    blk = jnp.arange(n_sel_blocks)[None, :]
    overlap = ((c_start < (blk + 1) * SEL_BLOCK) &
               (c_start + CMP_BLOCK > blk * SEL_BLOCK)).astype(jnp.float32)
    imp = jnp.einsum("bghsc,cn->bgsn", p_cmp, overlap)
    t = jnp.arange(s)[:, None]
    cur = t // SEL_BLOCK
    forced = (blk == 0) | (blk == cur) | (blk == cur - 1)
    causal = blk * SEL_BLOCK <= t
    score = jnp.where(forced, FORCE_SCORE, jnp.where(causal, imp, NEG_INF))
    n_top = min(SEL_TOPN, n_sel_blocks)
    _, idx = lax.top_k(score, n_top)
    return idx


def selected_branch(q, k_s, v_s, sel_idx, rel_tab, scale):
    b, g, hg, s, hd = q.shape
    n_top = sel_idx.shape[-1]
    n_chunks = s // SEL_QBLOCK
    n_keys = n_top * SEL_BLOCK
    kb = k_s.reshape(b, g, s // SEL_BLOCK, SEL_BLOCK, hd)
    vb = v_s.reshape(b, g, s // SEL_BLOCK, SEL_BLOCK, hd)
    bi = jnp.arange(b)[:, None, None, None]
    gi = jnp.arange(g)[None, :, None, None]
    offs = jnp.arange(SEL_BLOCK)
    q_c = jnp.moveaxis(q.reshape(b, g, hg, n_chunks, SEL_QBLOCK, hd), 3, 0)
    idx_c = jnp.moveaxis(sel_idx.reshape(b, g, n_chunks, SEL_QBLOCK, n_top), 2, 0)
    t_c = jnp.arange(s).reshape(n_chunks, SEL_QBLOCK)

    def one_step(args):
        qc, ic, tc = args
        kg = kb[bi, gi, ic].reshape(b, g, SEL_QBLOCK, n_keys, hd)
        vg = vb[bi, gi, ic].reshape(b, g, SEL_QBLOCK, n_keys, hd)
        kpos = (ic[..., None] * SEL_BLOCK + offs).reshape(b, g, SEL_QBLOCK, n_keys)
        dist = tc[:, None] - kpos
        bias = jnp.moveaxis(rel_tab[t5_bucket(dist), gi], -1, 2)
        logits = jnp.einsum("bghqd,bgqkd->bghqk", qc, kg,
                            preferred_element_type=jnp.float32) * scale + bias
        logits = jnp.where((dist >= 0)[:, :, None], logits, NEG_INF)
        p = jax.nn.softmax(logits, axis=-1)
        return jnp.einsum("bghqk,bgqkd->bghqd", p.astype(vg.dtype), vg)

    o = lax.map(one_step, (q_c, idx_c, t_c))
    return jnp.moveaxis(o, 0, 3).reshape(b, g, hg, s, hd)


def window_branch(q, k_w, v_w, rel_tab, scale):
    b, g, hg, s, hd = q.shape
    nb = s // WIN_QBLOCK
    n_prev = WINDOW // WIN_QBLOCK
    n_keys = (n_prev + 1) * WIN_QBLOCK

    def banded(z):
        zb = z.reshape(b, g, nb, WIN_QBLOCK, hd)
        zp = jnp.pad(zb, ((0, 0), (0, 0), (n_prev, 0), (0, 0), (0, 0)))
        return jnp.concatenate([zp[:, :, j:j + nb] for j in range(n_prev + 1)], axis=3)

    kw, vw = banded(k_w), banded(v_w)
    qw = q.reshape(b, g, hg, nb, WIN_QBLOCK, hd)
    dist = jnp.arange(WIN_QBLOCK)[:, None] + n_prev * WIN_QBLOCK - jnp.arange(n_keys)[None, :]
    kpos = jnp.arange(nb)[:, None] * WIN_QBLOCK - n_prev * WIN_QBLOCK + jnp.arange(n_keys)[None, :]
    mask = (dist >= 0) & (dist < WINDOW) & (kpos >= 0)[:, None, :]
    bias = jnp.transpose(rel_tab[t5_bucket(dist)], (2, 3, 0, 1))
    logits = jnp.einsum("bghnqd,bgnkd->bghnqk", qw, kw,
                        preferred_element_type=jnp.float32) * scale + bias[:, :, None]
    logits = jnp.where(mask, logits, NEG_INF)
    p = jax.nn.softmax(logits, axis=-1)
    o = jnp.einsum("bghnqk,bgnkd->bghnqd", p.astype(vw.dtype), vw)
    return o.reshape(b, g, hg, s, hd)


def native_sparse_attention(q, kc, vc, ks, vs, kw, vw, gate_logits, rel_tab, cmp_pe, cmp_w1, cmp_w2):
    b, s, _ = q.shape
    scale = HEAD_DIM ** -0.5
    qh = to_q_heads(q)
    kc_h, vc_h = to_kv_heads(kc), to_kv_heads(vc)
    n_cmp = (s - CMP_BLOCK) // CMP_STRIDE + 1
    blk_idx = jnp.arange(n_cmp)[:, None] * CMP_STRIDE + jnp.arange(CMP_BLOCK)[None, :]
    k_cmp = compress_blocks(kc_h[:, :, blk_idx], cmp_pe[0], cmp_w1[0], cmp_w2[0])
    v_cmp = compress_blocks(vc_h[:, :, blk_idx], cmp_pe[1], cmp_w1[1], cmp_w2[1])
    o_cmp, p_cmp = compressed_branch(qh, k_cmp, v_cmp, rel_tab, scale)
    sel_idx = select_blocks(p_cmp, s)
    o_slc = selected_branch(qh, to_kv_heads(ks), to_kv_heads(vs), sel_idx, rel_tab, scale)
    o_win = window_branch(qh, to_kv_heads(kw), to_kv_heads(vw), rel_tab, scale)
    gts = jax.nn.sigmoid(gate_logits.astype(jnp.float32)).reshape(
        b, s, KV_HEADS, HEADS_PER_GROUP, N_NSA_BRANCHES).transpose(0, 2, 3, 1, 4)
    o = gts[..., 0:1] * o_cmp + gts[..., 1:2] * o_slc + gts[..., 2:3] * o_win
    return o.astype(q.dtype).transpose(0, 3, 1, 2, 4).reshape(b, s, NSA_WIDTH)


def conformer_conv(glu_in, conv_w, conv_b, ln_g, ln_b):
    a, gate = jnp.split(glu_in, 2, axis=-1)
    u = a * jax.nn.sigmoid(gate)
    u = causal_depthwise_conv(u, conv_w) + conv_b.astype(u.dtype)
    return jax.nn.silu(layer_norm(u, ln_g, ln_b))


def short_gated_conv(sc_in, conv_w):
    bg, cg, xs = jnp.split(sc_in, 3, axis=-1)
    return bg * causal_depthwise_conv(cg * xs, conv_w)


def hierarchical_moe(h, rg_w, rg_b, re_w, re_b, we_g, we_u, we_d):
    t = h.shape[0]
    g_logits = (h @ rg_w).astype(jnp.float32) + rg_b.astype(jnp.float32)
    g_prob = jax.nn.softmax(g_logits, axis=-1)
    grp = jnp.argmax(g_logits, axis=-1)
    g_w = jnp.take_along_axis(g_prob, grp[:, None], axis=-1)
    e_logits = ((h @ re_w).astype(jnp.float32) + re_b.astype(jnp.float32)).reshape(
        t, N_GROUPS, EXPERTS_PER_GROUP)
    e_logits = jnp.take_along_axis(e_logits, grp[:, None, None], axis=1)[:, 0]
    e_prob = jax.nn.softmax(e_logits, axis=-1)
    top_p, top_i = lax.top_k(e_prob, TOPK_IN_GROUP)
    top_p = top_p / jnp.sum(top_p, axis=-1, keepdims=True)
    weights = g_w * top_p
    eid = grp[:, None] * EXPERTS_PER_GROUP + top_i
    combine = jnp.sum(jax.nn.one_hot(eid, N_EXPERTS, dtype=jnp.float32) * weights[..., None], axis=1)
    y = jnp.zeros(h.shape, jnp.float32)
    for e in range(N_EXPERTS):
        he = jax.nn.silu(h @ we_g[e]) * (h @ we_u[e])
        y = y + combine[:, e:e + 1] * (he @ we_d[e])
    return y.astype(h.dtype)


def hybrid_layer(x, p_i, rel_tab, attn_norm, w_in, cmp_pe, cmp_w1, cmp_w2,
                 conf_conv_w, conf_conv_b, conf_ln_g, conf_ln_b, sc_conv_w, w_branch, w_out,
                 ffn_norm, rg_w, rg_b, re_w, re_b, we_g, we_u, we_d,
                 ple_norm, ple_gate_w, ple_proj_w):
    b, s, d = x.shape
    h = rms_norm(x, attn_norm)
    z = h @ w_in
    q, kc, vc, ks, vs, kw, vw, nsa_g, conf_in, sc_in, merge_g = split_cols(z, IN_SPLITS)
    o_nsa = native_sparse_attention(q, kc, vc, ks, vs, kw, vw, nsa_g, rel_tab, cmp_pe, cmp_w1, cmp_w2)
    o_conf = conformer_conv(conf_in, conf_conv_w, conf_conv_b, conf_ln_g, conf_ln_b)
    o_sc = short_gated_conv(sc_in, sc_conv_w)
    gates = jax.nn.sigmoid(merge_g).reshape(b, s, N_BRANCHES, d)
    w_nsa, w_conf, w_sc = jnp.split(w_branch, [NSA_WIDTH, NSA_WIDTH + CONF_WIDTH], axis=0)
    merged = (gates[:, :, 0] * (o_nsa @ w_nsa) + gates[:, :, 1] * (o_conf @ w_conf)
              + gates[:, :, 2] * (o_sc @ w_sc))
    x = x + merged @ w_out
    h2 = rms_norm(x, ffn_norm).reshape(b * s, d)
    x = x + hierarchical_moe(h2, rg_w, rg_b, re_w, re_b, we_g, we_u, we_d).reshape(b, s, d)
    gate = jax.nn.sigmoid(rms_norm(x, ple_norm) @ ple_gate_w)
    return x + gate * (p_i @ ple_proj_w)


def setup_inputs(seed: int = 0) -> dict:
    key = jax.random.key(seed)
    ks = jax.random.split(key, 27)
    f32 = jnp.float32

    def nrm(k, shape, scale):
        return jax.random.normal(k, shape, f32) * scale

    def gain(k, shape):
        return 1.0 + 0.01 * jax.random.normal(k, shape, f32)

    L = DEPTH
    return {
        "x": nrm(ks[0], (BATCH, SEQ, D_MODEL), 1.0),
        "p": nrm(ks[1], (DEPTH, BATCH, SEQ, PLE_DIM), 1.0),
        "rel_bias": nrm(ks[2], (REL_BUCKETS, N_HEADS), 0.2),
        "attn_norm": gain(ks[3], (L, D_MODEL)),
        "w_in": nrm(ks[4], (L, D_MODEL, IN_WIDTH), D_MODEL ** -0.5),
        "cmp_pe": nrm(ks[5], (L, 2, CMP_BLOCK, HEAD_DIM), 0.1),
        "cmp_w1": nrm(ks[6], (L, 2, CMP_BLOCK * HEAD_DIM, CMP_HIDDEN), (CMP_BLOCK * HEAD_DIM) ** -0.5),
        "cmp_w2": nrm(ks[7], (L, 2, CMP_HIDDEN, HEAD_DIM), CMP_HIDDEN ** -0.5),
        "conf_conv_w": nrm(ks[8], (L, CONF_CONV_WIDTH, CONF_WIDTH), CONF_CONV_WIDTH ** -0.5),
        "conf_conv_b": nrm(ks[9], (L, CONF_WIDTH), 0.01),
        "conf_ln_g": gain(ks[10], (L, CONF_WIDTH)),
        "conf_ln_b": nrm(ks[11], (L, CONF_WIDTH), 0.01),
        "sc_conv_w": nrm(ks[12], (L, SC_CONV_WIDTH, SC_WIDTH), SC_CONV_WIDTH ** -0.5),
        "w_branch": nrm(ks[13], (L, MIX_WIDTH, D_MODEL), NSA_WIDTH ** -0.5),
        "w_out": nrm(ks[14], (L, D_MODEL, D_MODEL), D_MODEL ** -0.5),
        "ffn_norm": gain(ks[15], (L, D_MODEL)),
        "router_group_w": nrm(ks[16], (L, D_MODEL, N_GROUPS), D_MODEL ** -0.5),
        "router_group_b": nrm(ks[17], (L, N_GROUPS), 0.01),
        "router_expert_w": nrm(ks[18], (L, D_MODEL, N_EXPERTS), D_MODEL ** -0.5),
        "router_expert_b": nrm(ks[19], (L, N_EXPERTS), 0.01),
        "expert_w_gate": nrm(ks[20], (L, N_EXPERTS, D_MODEL, D_EXPERT), D_MODEL ** -0.5),
        "expert_w_up": nrm(ks[21], (L, N_EXPERTS, D_MODEL, D_EXPERT), D_MODEL ** -0.5),
        "expert_w_down": nrm(ks[22], (L, N_EXPERTS, D_EXPERT, D_MODEL), D_EXPERT ** -0.5),
        "ple_norm": gain(ks[23], (L, D_MODEL)),
        "ple_gate_w": nrm(ks[24], (L, D_MODEL, D_MODEL), D_MODEL ** -0.5),
        "ple_proj_w": nrm(ks[25], (L, PLE_DIM, D_MODEL), PLE_DIM ** -0.5),
        "final_norm": gain(ks[26], (D_MODEL,)),
    }


def reference(x, p, rel_bias, attn_norm, w_in, cmp_pe, cmp_w1, cmp_w2,
              conf_conv_w, conf_conv_b, conf_ln_g, conf_ln_b, sc_conv_w, w_branch, w_out,
              ffn_norm, router_group_w, router_group_b, router_expert_w, router_expert_b,
              expert_w_gate, expert_w_up, expert_w_down, ple_norm, ple_gate_w, ple_proj_w,
              final_norm):
    rel_tab = rel_bias.reshape(REL_BUCKETS, KV_HEADS, HEADS_PER_GROUP)
    for i in range(DEPTH):
        x = hybrid_layer(
            x, p[i], rel_tab, attn_norm[i], w_in[i], cmp_pe[i], cmp_w1[i], cmp_w2[i],
            conf_conv_w[i], conf_conv_b[i], conf_ln_g[i], conf_ln_b[i], sc_conv_w[i],
            w_branch[i], w_out[i], ffn_norm[i], router_group_w[i], router_group_b[i],
            router_expert_w[i], router_expert_b[i], expert_w_gate[i], expert_w_up[i],
            expert_w_down[i], ple_norm[i], ple_gate_w[i], ple_proj_w[i])
    return rms_norm(x, final_norm)
```

```cpp
#include <hip/hip_runtime.h>
#include <cstdio>
#include <cstdint>

#define LAS __attribute__((address_space(3)))
typedef unsigned short bf16_t;
typedef short bf16x8 __attribute__((ext_vector_type(8)));
typedef short s16x4 __attribute__((ext_vector_type(4)));
typedef float f32x4 __attribute__((ext_vector_type(4)));
typedef float f32x2 __attribute__((ext_vector_type(2)));
typedef float f32x16 __attribute__((ext_vector_type(16)));
typedef unsigned u32x4 __attribute__((ext_vector_type(4)));
typedef unsigned u32x2 __attribute__((ext_vector_type(2)));
typedef unsigned long long u64;
typedef __bf16 bfp2 __attribute__((ext_vector_type(2)));

constexpr int T = 16384, D = 2048, SEQ = 4096, NBATCH = 4, NLAYER = 2;
constexpr int LDZ = 6912;
constexpr int ZQ = 0, ZKV = 1024, ZCONF = 2560, ZSC = 3584, ZG24 = 6656;
constexpr int LDG = 7168, GCONF = 6144;
constexpr int IN_W = 13848;
constexpr int NSLOT = 40960;
constexpr int NTHREADS = 512;
constexpr float LOG2E = 1.4426950408889634f;
constexpr float RMS_EPS = 1e-6f;

constexpr size_t al256(size_t x) { return (x + 255) & ~(size_t)255; }
constexpr size_t WS_CTL = 0;
constexpr size_t CTL_BYTES = 65536;
constexpr size_t WS_WIN = WS_CTL + CTL_BYTES;
constexpr size_t WS_WMG = WS_WIN + (size_t)LDZ * 2048 * 2;
constexpr size_t WS_WC1 = WS_WIN + (size_t)14080 * 2048 * 2;
constexpr size_t WS_WC2 = WS_WC1 + (size_t)2 * 512 * 4096 * 2;
constexpr size_t WS_WBR = WS_WC2 + (size_t)256 * 512 * 2;
constexpr size_t WS_WOUT = WS_WBR + (size_t)2048 * 3072 * 2;
constexpr size_t WS_WR = WS_WOUT + (size_t)2048 * 2048 * 2;
constexpr size_t WS_WGU = WS_WR + (size_t)256 * 2048 * 2;
constexpr size_t WS_WD = WS_WGU + (size_t)32 * 1024 * 2048 * 2;
constexpr size_t WS_WPG = WS_WD + (size_t)32 * 2048 * 512 * 2;
constexpr size_t WS_WPP = WS_WPG + (size_t)2048 * 2048 * 2;
constexpr size_t WS_B1P = WS_WPP + (size_t)2048 * 256 * 2;
constexpr size_t WS_B1 = WS_B1P + (size_t)2 * 64 * 512 * 4;
constexpr size_t WS_H = al256(WS_B1 + 2 * 512 * 4);
constexpr size_t WS_Z = WS_H + (size_t)T * 2048 * 2;
constexpr size_t Z_BYTES = (size_t)(T + 32) * LDZ * 2;
constexpr size_t WS_OB = WS_Z + Z_BYTES;
constexpr size_t WS_MRG = WS_OB + (size_t)T * 3072 * 2;
constexpr size_t WS_HID = WS_MRG + (size_t)T * 2048 * 2;
constexpr size_t WS_KCMP = WS_HID + (size_t)4096 * 512 * 2;
constexpr size_t WS_VCMP = WS_KCMP + (size_t)8 * 256 * 128 * 2;
constexpr size_t WS_PB = WS_VCMP + (size_t)8 * 256 * 128 * 2;
constexpr size_t WS_LOG = WS_PB + (size_t)T * 256 * 2;
constexpr size_t WS_TOKE = WS_LOG + (size_t)4 * T * 64 * 4;
constexpr size_t WS_TOKP = WS_TOKE + (size_t)T * 2 * 4;
constexpr size_t WS_TOKW = WS_TOKP + (size_t)T * 2 * 4;
constexpr size_t WS_STOK = WS_TOKW + (size_t)T * 2 * 4;
constexpr size_t WS_SDST = WS_STOK + (size_t)NSLOT * 4;
constexpr size_t WS_SW = WS_SDST + (size_t)NSLOT * 4;
constexpr size_t WS_TEXP = WS_SW + (size_t)NSLOT * 4;
constexpr size_t WS_GB = al256(WS_TEXP + 1024);
constexpr size_t WS_H8 = WS_GB + (size_t)T * LDG * 2;
constexpr size_t WS_XR = WS_H8 + (size_t)T * 2048;
constexpr size_t WS_RS = WS_XR + (size_t)T * 2048 * 2;
constexpr size_t WS_END = WS_RS + (size_t)T * 4;
constexpr size_t WS_HE = WS_Z;
constexpr size_t WS_YB = WS_HE + (size_t)NSLOT * 512;
constexpr size_t WS_PP = WS_YB + (size_t)(2 * T + 8) * 2048 * 2;
static_assert(WS_PP + (size_t)T * 2048 * 2 <= WS_Z + Z_BYTES, "aliases must fit in z");
constexpr int CW_BAR = 0;
constexpr int CW_CNT = 4096;
constexpr int CW_NTILE = 4096 + 128;

constexpr int LDS_STAGE = 0;
constexpr int LDS_MISC = 131072;
constexpr int LDS_BYTES = 131072 + 20480;

#define XB_TMO      128
#define XB_XCNT(j)  (256  + 64 * (j))
#define XB_XSUB(j)  (1280 + 64 * (j))
#define XB_XGEN(j)  (2304 + 64 * (j))
#define XB_TOP      3328
#define XB_TOPGEN   3392
#define XCD_BAR_WORDS 3456
#define XB_SPIN_CAP (1u << 20)
__device__ __forceinline__ unsigned xb_ld(unsigned* p)              { return __hip_atomic_load(p, __ATOMIC_RELAXED, __HIP_MEMORY_SCOPE_AGENT); }
__device__ __forceinline__ unsigned xb_add(unsigned* p, unsigned v) { return __hip_atomic_fetch_add(p, v, __ATOMIC_RELAXED, __HIP_MEMORY_SCOPE_AGENT); }
__device__ __forceinline__ unsigned xb_xcc_id() { return (unsigned)__builtin_amdgcn_s_getreg((3 << 11) | 20) & 0xFu; }
#define XB_SPIN(cond, bar) do { unsigned _sp = 0; while (cond) { __builtin_amdgcn_s_sleep(1); \
    if ((++_sp & 255u) == 0u) { if (xb_ld(&(bar)[XB_TMO])) break; if (_sp > XB_SPIN_CAP) { atomicAdd(&(bar)[XB_TMO], 1u); break; } } } } while (0)
struct XcdBarrier { unsigned* bar; unsigned x; volatile LAS unsigned* st; };
__device__ __forceinline__ XcdBarrier xcd_barrier_post(unsigned* bar, volatile LAS unsigned* st) {
    XcdBarrier b; b.bar = bar; b.x = xb_xcc_id(); b.st = st;
    if (threadIdx.x == 0) (void)xb_add(&bar[XB_XCNT(b.x)], 1u);
    return b;
}
__device__ __forceinline__ void xcd_barrier_complete(unsigned* bar, unsigned x, unsigned& nloc, unsigned& nx) {
    const unsigned G = gridDim.x * gridDim.y * gridDim.z;
    unsigned sum, cnt, mine, sp = 0u;
    for (;;) {
        sum = 0u; cnt = 0u; mine = 0u;
#pragma unroll
        for (unsigned j = 0; j < 16; ++j) { const unsigned c = xb_ld(&bar[XB_XCNT(j)]); sum += c; cnt += (c > 0u) ? 1u : 0u; mine = (j == x) ? c : mine; }
        if (sum == G) break;
        __builtin_amdgcn_s_sleep(1);
        if ((++sp & 255u) == 0u) { if (xb_ld(&bar[XB_TMO])) break; if (sp > XB_SPIN_CAP) { atomicAdd(&bar[XB_TMO], 1u); break; } }
    }
    nloc = mine > 0u ? mine : 1u; nx = cnt > 0u ? cnt : 1u;
}
__device__ __forceinline__ void xcd_barrier(const XcdBarrier& b) {
    asm volatile("s_waitcnt vmcnt(0)" ::: "memory");
    __syncthreads();
    if (threadIdx.x == 0) {
        unsigned bx = b.x; __attribute__((address_space(1))) unsigned* barg = (__attribute__((address_space(1))) unsigned*)b.bar;
        asm volatile("" : "+s"(barg), "+s"(bx)); unsigned* bar = (unsigned*)barg;
        __builtin_amdgcn_s_waitcnt(0);
        unsigned nloc = b.st[0], nx = b.st[1];
        if (nloc == 0u) { xcd_barrier_complete(bar, bx, nloc, nx); b.st[0] = nloc; b.st[1] = nx; }
        const unsigned old = xb_add(&bar[XB_XSUB(bx)], 1u);
        const unsigned gen = old / nloc;
        if (old + 1u == (gen + 1u) * nloc) {
            __builtin_amdgcn_fence(__ATOMIC_RELEASE, "agent");
            asm volatile("s_waitcnt vmcnt(0)" ::: "memory");
            const unsigned og = xb_add(&bar[XB_TOP], 1u);
            const unsigned tg = og / nx;
            if (og + 1u == (tg + 1u) * nx) xb_add(&bar[XB_TOPGEN], 1u);
            else XB_SPIN(xb_ld(&bar[XB_TOPGEN]) == tg, bar);
            __builtin_amdgcn_fence(__ATOMIC_ACQUIRE, "agent");
            xb_add(&bar[XB_XGEN(bx)], 1u);
            asm volatile("s_waitcnt vmcnt(0)" ::: "memory");
        } else {
            XB_SPIN(xb_ld(&bar[XB_XGEN(bx)]) == gen, bar);
            __builtin_amdgcn_fence(__ATOMIC_ACQUIRE, "agent");
            asm volatile("s_waitcnt vmcnt(0)" ::: "memory");
        }
    }
    __syncthreads();
}

__device__ __forceinline__ unsigned cvtpk(float lo, float hi) { unsigned r; asm volatile("v_cvt_pk_bf16_f32 %0, %1, %2" : "=v"(r) : "v"(lo), "v"(hi)); return r; }
__device__ __forceinline__ float bf2f(unsigned short b) { return __uint_as_float(((unsigned)b) << 16); }
__device__ __forceinline__ float bflo(unsigned w) { return __uint_as_float(w << 16); }
__device__ __forceinline__ float bfhi(unsigned w) { return __uint_as_float(w & 0xffff0000u); }
__device__ __forceinline__ float sigmoidf_(float x) { return __builtin_amdgcn_rcpf(1.0f + __builtin_amdgcn_exp2f(-x * LOG2E)); }
__device__ __forceinline__ float siluf_(float x) { return x * sigmoidf_(x); }
__device__ __forceinline__ float gelu_tanh(float x) { return x * sigmoidf_(1.5957691216057308f * (x + 0.044715f * x * x * x)); }
__device__ __forceinline__ u32x4 pack8f(const f32x4 a, const f32x4 b) { u32x4 w; w.x = cvtpk(a[0], a[1]); w.y = cvtpk(a[2], a[3]); w.z = cvtpk(b[0], b[1]); w.w = cvtpk(b[2], b[3]); return w; }
__device__ __forceinline__ int opaque_s0(int v) { asm volatile("" : "+s"(v)); return v; }
__device__ __forceinline__ int otid() { int t = threadIdx.x; asm volatile("" : "+v"(t)); return t; }
__device__ __forceinline__ float wave_sum(float v) {
#pragma unroll
    for (int o = 32; o >= 1; o >>= 1) v += __shfl_xor(v, o);
    return v;
}

namespace pg8 {
constexpr int BM = 256, BK = 64, HALF = 128, HTB = HALF * BK * 2, STAGE_BYTES = 8 * HTB, NXCD = 8, WGM = 8;
__host__ __device__ __forceinline__ int lds_byte(int r, int c) { const int st = (r >> 4) * 2 + (c >> 5), rr = r & 15, cc = c & 31, ob = rr * 64 + cc * 2; return st * 1024 + (ob ^ (((ob >> 9) & 1) << 5)); }
__host__ __device__ __forceinline__ void stage_rc(int b, int& R, int& C) { const int st = b / 1024, sb = b % 1024, swz = sb ^ (((sb >> 9) & 1) << 5); R = (st >> 1) * 16 + swz / 64; C = (st & 1) * 32 + (swz % 64) / 2; }
__host__ __device__ __forceinline__ int perm32(int rho) { const int n = rho >> 4, i = rho & 15; return 8 * (i >> 2) + 4 * n + (i & 3); }
struct Unit { int pm, pn, aux; };
typedef int v8i __attribute__((ext_vector_type(8)));
typedef int v4i __attribute__((ext_vector_type(4)));
__device__ __forceinline__ v8i cat8(const bf16x8 a, const bf16x8 b) { typedef int v4i __attribute__((ext_vector_type(4))); const v4i x = __builtin_bit_cast(v4i, a), y = __builtin_bit_cast(v4i, b); return (v8i){x[0], x[1], x[2], x[3], y[0], y[1], y[2], y[3]}; }

__device__ __forceinline__ bool static_unit(int L, int nM, int nN, Unit& u) {
    const int nwg = nM * nN; if (L >= nwg) return false;
    int wgid = L; { const int q = nwg / NXCD, r = nwg % NXCD, xcd = wgid % NXCD, off = wgid / NXCD; wgid = (xcd < r ? xcd * (q + 1) : r * (q + 1) + (xcd - r) * q) + off; }
    const int nig = WGM * nN, gid = wgid / nig, fm = gid * WGM, gsz = (nM - fm) < WGM ? (nM - fm) : WGM;
    u.pm = fm + ((wgid % nig) % gsz); u.pn = (wgid % nig) / gsz; u.aux = 0; return true;
}

template <class P>
__device__ __forceinline__ void gemm_phase(LAS unsigned char* lds, const P& p) {
    const int tid = otid(), wid = __builtin_amdgcn_readfirstlane(tid >> 6), lane = tid & 63, wr = wid >> 2, wc = wid & 3, fr = lane & 15, fq = lane >> 4;
    Unit cur, nxt; int ui = 0;
    if (!p.next(0, cur)) return;
    int Rr[2], Cc[2]; unsigned voffB[2][2], voffA[2][2], nvoffA[2][2];
    const int ldb = p.ldb();
#pragma unroll
    for (int i = 0; i < 2; ++i) { int R, C; stage_rc(tid * 16 + i * 8192, R, C); Rr[i] = R; Cc[i] = C; const int Rb = (R & ~31) + perm32(R & 31);
#pragma unroll
        for (int h = 0; h < 2; ++h) { voffB[h][i] = (unsigned)(Rb * ldb + C) * 2u; voffA[h][i] = p.a_off(cur, h, R, C); nvoffA[h][i] = voffA[h][i]; } }
    const size_t hB = (size_t)HALF * ldb * 2, hA = p.a_hofs();
    const unsigned ldsw = (unsigned)wid * 1024u;
    const int aoff = lds_byte(wr * 64 + fr, fq * 8), boff = lds_byte(wc * 32 + fr, fq * 8);
#define PG8_SA(b, h) (((b) * 2 + (h)) * HTB)
#define PG8_SB(b, h) ((4 + (b) * 2 + (h)) * HTB)
#define PG8_STAGE(bufoff, gbase, voff) do { _Pragma("unroll") for (int _i = 0; _i < 2; ++_i) \
        __builtin_amdgcn_global_load_lds((const unsigned*)((const char*)(gbase) + (voff)[_i]), (LAS unsigned*)(lds + (bufoff) + ldsw + _i * 8192), 16, 0, 0); } while (0)
#define PG8_LD8(p_) __builtin_shufflevector(*(const LAS v4i*)(p_), *(const LAS v4i*)((p_) + 1024), 0, 1, 2, 3, 4, 5, 6, 7)
#define PG8_LDA(dst, b, h) do { if constexpr (P::FP8) { _Pragma("unroll") for (int m = 0; m < 4; ++m) dst##8[m] = PG8_LD8(lds + PG8_SA(b, h) + aoff + m * 2048); } \
        else { _Pragma("unroll") for (int m = 0; m < 4; ++m) _Pragma("unroll") for (int k = 0; k < 2; ++k) dst[m][k] = *(const LAS bf16x8*)(lds + PG8_SA(b, h) + aoff + m * 2048 + k * 1024); } } while (0)
#define PG8_LDB(dst, b, h) do { if constexpr (P::FP8) { _Pragma("unroll") for (int n = 0; n < 2; ++n) dst##8[n] = PG8_LD8(lds + PG8_SB(b, h) + boff + n * 2048); } \
        else { _Pragma("unroll") for (int n = 0; n < 2; ++n) _Pragma("unroll") for (int k = 0; k < 2; ++k) dst[n][k] = *(const LAS bf16x8*)(lds + PG8_SB(b, h) + boff + n * 2048 + k * 1024); } } while (0)
#define PG8_MMA(ai, bj, At, Bt) do { __builtin_amdgcn_s_setprio(1); \
        if constexpr (P::FP8) { _Pragma("unroll") for (int m = 0; m < 4; ++m) _Pragma("unroll") for (int n = 0; n < 2; ++n) \
            asm volatile("v_mfma_scale_f32_16x16x128_f8f6f4 %0, %1, %2, %0, %3, %3 op_sel_hi:[0,0,0]" : "+v"(acc[ai][bj][m][n]) : "v"(Bt##8[n]), "v"(At##8[m]), "v"(sc127)); } \
        else { _Pragma("unroll") for (int m = 0; m < 4; ++m) _Pragma("unroll") for (int n = 0; n < 2; ++n) _Pragma("unroll") for (int k = 0; k < 2; ++k) \
            acc[ai][bj][m][n] = __builtin_amdgcn_mfma_f32_16x16x32_bf16(Bt[n][k], At[m][k], acc[ai][bj][m][n], 0, 0, 0); } \
        __builtin_amdgcn_s_setprio(0); } while (0)
#define PG8_WAIT_V(n) asm volatile("s_waitcnt vmcnt(" #n ")" ::: "memory")
#define PG8_WAIT_L(n) asm volatile("s_waitcnt lgkmcnt(" #n ")" ::: "memory")
#define PG8_BAR __builtin_amdgcn_s_barrier()
#define PG8_SCHED __builtin_amdgcn_sched_barrier(0)
    float zf = 0.f; asm volatile("" : "+v"(zf));
    f32x4 acc[2][2][4][2];
#pragma unroll
    for (int a = 0; a < 2; ++a)
#pragma unroll
        for (int b = 0; b < 2; ++b)
#pragma unroll
            for (int m = 0; m < 4; ++m)
#pragma unroll
                for (int n = 0; n < 2; ++n) acc[a][b][m][n] = (f32x4){zf, zf, zf, zf};
    const int sc127 = 127;
    bf16x8 At[4][2], B0[2][2], B1[2][2]; v8i At8[4], B08[2], B18[2];
    const char* cA = p.a_base(cur); const char* cB = p.b_base(cur);
    const size_t k1a = p.a_kofs(1);
    PG8_STAGE(PG8_SB(0, 0), cB, voffB[0]); PG8_STAGE(PG8_SB(0, 1), cB + hB, voffB[1]); PG8_STAGE(PG8_SA(0, 0), cA, voffA[0]); PG8_STAGE(PG8_SA(0, 1), cA + hA, voffA[1]);
    if (wr == 1) PG8_BAR;
    PG8_WAIT_V(2); PG8_BAR;
    PG8_STAGE(PG8_SB(1, 0), cB + 128, voffB[0]); PG8_STAGE(PG8_SA(1, 0), cA + k1a, voffA[0]); PG8_STAGE(PG8_SB(1, 1), cB + hB + 128, voffB[1]);
    PG8_WAIT_V(6); PG8_BAR;
    for (;;) {
        const bool has_next = p.next(ui + 1, nxt);
        const int nt = p.nt(cur);
        const char* nA = has_next ? p.a_base(nxt) : cA; const char* nB = has_next ? p.b_base(nxt) : cB;
        if constexpr (P::A_PER_UNIT) { if (has_next) {
#pragma unroll
            for (int i = 0; i < 2; ++i)
#pragma unroll
                for (int h = 0; h < 2; ++h) nvoffA[h][i] = p.a_off(nxt, h, Rr[i], Cc[i]);
            asm volatile("" : "+v"(nvoffA[0][0]), "+v"(nvoffA[0][1]), "+v"(nvoffA[1][0]), "+v"(nvoffA[1][1])); } }
        for (int t = 0; t < nt; t += 2) {
            const bool last = (t == nt - 2);
            const char* a1 = cA + p.a_kofs(t + 1);
            const char* a2 = last ? nA : cA + p.a_kofs(t + 2); const char* b2 = last ? nB : cB + (size_t)(t + 2) * 128;
            const char* a3 = last ? nA + k1a : cA + p.a_kofs(t + 3); const char* b3 = b2 + 128;
            unsigned vA0[2], vA1[2];
            if constexpr (P::A_PER_UNIT) { vA0[0] = last ? nvoffA[0][0] : voffA[0][0]; vA0[1] = last ? nvoffA[0][1] : voffA[0][1]; vA1[0] = last ? nvoffA[1][0] : voffA[1][0]; vA1[1] = last ? nvoffA[1][1] : voffA[1][1]; }
            else { vA0[0] = voffA[0][0]; vA0[1] = voffA[0][1]; vA1[0] = voffA[1][0]; vA1[1] = voffA[1][1]; }
            PG8_LDB(B0, 0, 0); PG8_LDB(B1, 0, 1); PG8_SCHED; PG8_LDA(At, 0, 0); PG8_STAGE(PG8_SA(1, 1), a1 + hA, voffA[1]);
            PG8_WAIT_V(8); PG8_WAIT_L(0); PG8_BAR; PG8_MMA(0, 0, At, B0); PG8_MMA(0, 1, At, B1); PG8_BAR; PG8_SCHED;
            PG8_LDA(At, 0, 1); PG8_STAGE(PG8_SB(0, 0), b2, voffB[0]); PG8_STAGE(PG8_SB(0, 1), b2 + hB, voffB[1]); PG8_STAGE(PG8_SA(0, 0), a2, vA0);
            PG8_WAIT_V(8); PG8_WAIT_L(0); PG8_BAR; PG8_MMA(1, 0, At, B0); PG8_MMA(1, 1, At, B1); PG8_BAR; PG8_SCHED;
            PG8_LDB(B0, 1, 0); PG8_LDB(B1, 1, 1); PG8_SCHED; PG8_LDA(At, 1, 0); PG8_STAGE(PG8_SA(0, 1), a2 + hA, vA1);
            PG8_WAIT_V(8); PG8_WAIT_L(0); PG8_BAR; PG8_MMA(0, 0, At, B0); PG8_MMA(0, 1, At, B1); PG8_BAR; PG8_SCHED;
            PG8_LDA(At, 1, 1); PG8_STAGE(PG8_SB(1, 0), b3, voffB[0]); PG8_STAGE(PG8_SB(1, 1), b3 + hB, voffB[1]); PG8_STAGE(PG8_SA(1, 0), a3, vA0);
            PG8_WAIT_V(8); PG8_WAIT_L(0); PG8_BAR; PG8_MMA(1, 0, At, B0); PG8_MMA(1, 1, At, B1); PG8_BAR; PG8_SCHED;
        }
        if (wr == 0) PG8_BAR;
        p.epi(acc, cur, wr, wc, fr, fq);
        if (!has_next) break;
        zf = 0.f; asm volatile("" : "+v"(zf));
#pragma unroll
        for (int a = 0; a < 2; ++a)
#pragma unroll
            for (int b = 0; b < 2; ++b)
#pragma unroll
                for (int m = 0; m < 4; ++m)
#pragma unroll
                    for (int n = 0; n < 2; ++n) acc[a][b][m][n] = (f32x4){zf, zf, zf, zf};
        cur = nxt; cA = nA; cB = nB; ++ui;
        if constexpr (P::A_PER_UNIT) {
#pragma unroll
            for (int i = 0; i < 2; ++i)
#pragma unroll
                for (int h = 0; h < 2; ++h) voffA[h][i] = nvoffA[h][i]; }
        if (wr == 1) PG8_BAR;
    }
    PG8_WAIT_V(0);
    PG8_BAR;
#undef PG8_SA
#undef PG8_SB
#undef PG8_STAGE
#undef PG8_LDA
#undef PG8_LDB
#undef PG8_MMA
#undef PG8_WAIT_V
#undef PG8_WAIT_L
#undef PG8_BAR
#undef PG8_SCHED
}
}
typedef f32x4 Acc[2][2][4][2];

struct Params {
    const float* in[27];
    float* out;
    unsigned char* ws;
    int ph_lo, ph_hi;
    int use_bar, pad;
};
enum { I_X = 0, I_P, I_REL, I_ANORM, I_WIN, I_PE, I_W1, I_W2, I_CCW, I_CCB, I_CLG, I_CLB, I_SCW, I_WBR, I_WOUT, I_FNORM, I_RGW, I_RGB, I_REW, I_REB, I_WG, I_WU, I_WD, I_PNORM, I_PGW, I_PPW, I_FINAL };

typedef const __attribute__((address_space(4))) Params* KP;
struct Ctx {
    KP p; int layer; int G, c;
    LAS unsigned char* lds;
    unsigned char* ws;
#define GAS __attribute__((address_space(1)))
#define WSP(name, type, off) __device__ __forceinline__ type* name() const { return (type*)(ws + (off)); }
    __device__ __forceinline__ const float* in(int i) const { GAS const float* g = (GAS const float*)p->in[i]; asm volatile("" : "+s"(g)); return (const float*)g; }
    WSP(ctl, unsigned, WS_CTL)
    WSP(Win, bf16_t, WS_WIN) WSP(Wc1, bf16_t, WS_WC1) WSP(Wc2, bf16_t, WS_WC2) WSP(Wbr, bf16_t, WS_WBR) WSP(Wout, bf16_t, WS_WOUT)
    WSP(Wr, bf16_t, WS_WR) WSP(Wgu, bf16_t, WS_WGU) WSP(Wd, bf16_t, WS_WD) WSP(Wpg, bf16_t, WS_WPG) WSP(Wpp, bf16_t, WS_WPP)
    WSP(b1p, float, WS_B1P) WSP(b1, float, WS_B1)
    WSP(H, bf16_t, WS_H) WSP(H8, unsigned char, WS_H8) WSP(XR, bf16_t, WS_XR) WSP(RS, float, WS_RS) WSP(GB, bf16_t, WS_GB) WSP(Wmg, unsigned char, WS_WMG) WSP(Z, bf16_t, WS_Z) WSP(OB, bf16_t, WS_OB) WSP(MRG, bf16_t, WS_MRG) WSP(HID, bf16_t, WS_HID)
    WSP(KCMP, bf16_t, WS_KCMP) WSP(VCMP, bf16_t, WS_VCMP) WSP(PB, bf16_t, WS_PB) WSP(HE, bf16_t, WS_HE) WSP(YB, bf16_t, WS_YB) WSP(PP, bf16_t, WS_PP)
    WSP(LOG, float, WS_LOG) WSP(toke, int, WS_TOKE) WSP(tokp, int, WS_TOKP) WSP(tokw, float, WS_TOKW)
    WSP(stok, int, WS_STOK) WSP(sdst, int, WS_SDST) WSP(sw, float, WS_SW) WSP(texp, int, WS_TEXP)
#undef WSP
    float* x;
};
__device__ __forceinline__ unsigned char* launder(unsigned char* p) { GAS unsigned char* g = (GAS unsigned char*)p; asm volatile("" : "+s"(g)); return (unsigned char*)g; }
__device__ __forceinline__ bool runp(int lo, int hi, int ph) { asm volatile("" : "+s"(lo), "+s"(hi)); return lo <= ph && ph < hi; }
__device__ __forceinline__ KP launder_kp() { KP k = (KP)__builtin_amdgcn_kernarg_segment_ptr(); asm volatile("" : "+s"(k)); return k; }
__device__ __forceinline__ int opaque_s(int v) { asm volatile("" : "+s"(v)); return v; }
#define PHASE_ENTER() do { C.p = launder_kp(); C.ws = launder(C.p->ws); C.c = opaque_s((int)blockIdx.x); C.G = opaque_s((int)gridDim.x); { LAS unsigned char* l_ = lds; asm volatile("" : "+s"(l_)); C.lds = l_; } } while (0)

__device__ __forceinline__ void cvt_tile(LAS float* tl, const float* src, int ld_src, int c0, int k0, bf16_t* dst, int ldd, int n0) {
    const int tid = otid();
#pragma unroll
    for (int j = 0; j < 4; ++j) { const int r = (tid >> 4) + 32 * j, cc = (tid & 15) * 4;
        const f32x4 v = *(const f32x4*)(src + (size_t)(k0 + r) * ld_src + c0 + cc);
        tl[(cc + 0) * 129 + r] = v[0]; tl[(cc + 1) * 129 + r] = v[1]; tl[(cc + 2) * 129 + r] = v[2]; tl[(cc + 3) * 129 + r] = v[3]; }
    __syncthreads();
    { const int n = tid >> 3, ks = (tid & 7) * 16; const LAS float* rp = tl + n * 129 + ks;
      f32x4 a, b, c, d; a = (f32x4){rp[0], rp[1], rp[2], rp[3]}; b = (f32x4){rp[4], rp[5], rp[6], rp[7]}; c = (f32x4){rp[8], rp[9], rp[10], rp[11]}; d = (f32x4){rp[12], rp[13], rp[14], rp[15]};
      bf16_t* dp = dst + (size_t)(n0 + n) * ldd + k0 + ks;
      *(u32x4*)dp = pack8f(a, b); *(u32x4*)(dp + 8) = pack8f(c, d); }
    __syncthreads();
}
__device__ __forceinline__ unsigned pk4_fp8(float a, float b, float c, float d) { unsigned w = 0; w = __builtin_amdgcn_cvt_pk_fp8_f32(a, b, w, false); w = __builtin_amdgcn_cvt_pk_fp8_f32(c, d, w, true); return w; }
__device__ __forceinline__ void cvt_tile8(LAS float* tl, const float* src, int ld_src, int c0, int k0, unsigned char* dst, int ldd, int n0, float scale) {
    const int tid = otid();
#pragma unroll
    for (int j = 0; j < 4; ++j) { const int r = (tid >> 4) + 32 * j, cc = (tid & 15) * 4;
        const f32x4 v = *(const f32x4*)(src + (size_t)(k0 + r) * ld_src + c0 + cc);
        tl[(cc + 0) * 129 + r] = v[0]; tl[(cc + 1) * 129 + r] = v[1]; tl[(cc + 2) * 129 + r] = v[2]; tl[(cc + 3) * 129 + r] = v[3]; }
    __syncthreads();
    { const int n = tid >> 3, ks = (tid & 7) * 16; const LAS float* rp = tl + n * 129 + ks; u32x4 w;
      w.x = pk4_fp8(rp[0] * scale, rp[1] * scale, rp[2] * scale, rp[3] * scale); w.y = pk4_fp8(rp[4] * scale, rp[5] * scale, rp[6] * scale, rp[7] * scale);
      w.z = pk4_fp8(rp[8] * scale, rp[9] * scale, rp[10] * scale, rp[11] * scale); w.w = pk4_fp8(rp[12] * scale, rp[13] * scale, rp[14] * scale, rp[15] * scale);
      *(u32x4*)(dst + (size_t)(n0 + n) * ldd + k0 + ks) = w; }
    __syncthreads();
}
__device__ __forceinline__ void phase_prologue(const Ctx& C) {
    const int l = C.layer, tid = otid();
    LAS float* tl = (LAS float*)(C.lds + LDS_STAGE);
    constexpr int J_WIN = 220 * 16, J_C1 = 2 * 8 * 32, J_C2 = 4 * 4, J_BR = 32 * 24, J_OUT = 32 * 16, J_GU = 32 * 16 * 16, J_D = 32 * 32 * 4, J_PG = 32 * 16, J_PP = 32 * 2;
    constexpr int E0 = J_WIN, E1 = E0 + J_C1, E2 = E1 + J_C2, E3 = E2 + J_BR, E4 = E3 + J_OUT, E5 = E4 + J_GU, E6 = E5 + J_D, E7 = E6 + J_PG, E8 = E7 + J_PP;
    struct Job { const float* src; int ld, c0, k0; unsigned char* dst; int ldd, n0, f8; float scale; };
    auto decode = [&](int j, Job& J) {
        if (j < E0) { const int nt_ = j / 16, kc = j % 16; J.src = C.in(I_WIN) + (size_t)l * 2048 * IN_W; J.ld = IN_W; J.k0 = kc * 128;
            if (nt_ < 68) { const int n0 = ZCONF + nt_ * 64; const int w_ = n0 - (ZSC + 1024);
                J.c0 = n0 < ZSC ? n0 - ZCONF + 2584 : (n0 < ZSC + 1024 ? n0 - ZSC + 4632 : (n0 < ZG24 ? 5656 + ((w_ >> 7) & 1) * 1024 + (w_ >> 8) * 128 + (w_ & 127) : 2560)); J.dst = (unsigned char*)C.Win(); J.ldd = 2048; J.n0 = n0; J.f8 = 0; J.scale = 1.f; }
            else { const int n0 = (nt_ - 68) * 64; J.c0 = n0 < GCONF ? 7704 + n0 : (n0 < LDG ? 3608 + (n0 - GCONF) : n0 - LDG); J.dst = C.Wmg(); J.ldd = 2048; J.n0 = n0; J.f8 = 1; J.scale = 64.f; } }
        else if (j < E1) { const int q = j - E0, kv = q / 256, r = q % 256, nt_ = r / 32, kc = r % 32; J.src = C.in(I_W1) + (size_t)(l * 2 + kv) * 4096 * 512; J.ld = 512; J.c0 = nt_ * 64; J.k0 = kc * 128; J.dst = (unsigned char*)(C.Wc1() + (size_t)kv * 512 * 4096); J.ldd = 4096; J.n0 = nt_ * 64; J.f8 = 0; J.scale = 1.f; }
        else if (j < E2) { const int q = j - E1, nt_ = q / 4, kc = q % 4, kv = nt_ >> 1; J.src = C.in(I_W2) + (size_t)(l * 2 + kv) * 512 * 128; J.ld = 128; J.c0 = (nt_ & 1) * 64; J.k0 = kc * 128; J.dst = (unsigned char*)C.Wc2(); J.ldd = 512; J.n0 = nt_ * 64; J.f8 = 0; J.scale = 1.f; }
        else if (j < E3) { const int q = j - E2, nt_ = q / 24, kc = q % 24; J.src = C.in(I_WBR) + (size_t)l * 3072 * 2048; J.ld = 2048; J.c0 = nt_ * 64; J.k0 = kc * 128; J.dst = (unsigned char*)C.Wbr(); J.ldd = 3072; J.n0 = nt_ * 64; J.f8 = 0; J.scale = 1.f;
            if (kc < 16) { J.src += (size_t)(kc >> 3) * 1024 * 2048; J.k0 = (kc & 7) * 128; J.dst += kc < 8 ? 3072 : 2048; J.ldd = 6144; J.f8 = 1; J.scale = 64.f; } }
        else if (j < E4) { const int q = j - E3, nt_ = q / 16, kc = q % 16; J.src = C.in(I_WOUT) + (size_t)l * 2048 * 2048; J.ld = 2048; J.c0 = nt_ * 64; J.k0 = kc * 128; J.dst = (unsigned char*)C.Wout(); J.ldd = 2048; J.n0 = nt_ * 64; J.f8 = 0; J.scale = 1.f; }
        else if (j < E5) { const int q = j - E4, e = q / 256, r = q % 256, nt_ = r / 16, kc = r % 16, n0 = nt_ * 64; const int pn = n0 >> 8, bj = (n0 >> 7) & 1, i0 = n0 & 127;
            J.src = (bj ? C.in(I_WU) : C.in(I_WG)) + (size_t)(l * 32 + e) * 2048 * 512; J.ld = 512; J.c0 = pn * 128 + i0; J.k0 = kc * 128; J.dst = (unsigned char*)C.Wgu() + (size_t)e * 1024 * 2048; J.ldd = 2048; J.n0 = n0; J.f8 = 1; J.scale = 64.f; }
        else if (j < E6) { const int q = j - E5, e = q / 128, r = q % 128, nt_ = r / 4, kc = r % 4; J.src = C.in(I_WD) + (size_t)(l * 32 + e) * 512 * 2048; J.ld = 2048; J.c0 = nt_ * 64; J.k0 = kc * 128; J.dst = (unsigned char*)C.Wd() + (size_t)e * 2048 * 512; J.ldd = 512; J.n0 = nt_ * 64; J.f8 = 1; J.scale = 32.f; }
        else if (j < E7) { const int q = j - E6, nt_ = q / 16, kc = q % 16; J.src = C.in(I_PGW) + (size_t)l * 2048 * 2048; J.ld = 2048; J.c0 = nt_ * 64; J.k0 = kc * 128; J.dst = (unsigned char*)C.Wpg(); J.ldd = 2048; J.n0 = nt_ * 64; J.f8 = 1; J.scale = 64.f; }
        else { const int q = j - E7, nt_ = q / 2, kc = q % 2; J.src = C.in(I_PPW) + (size_t)l * 256 * 2048; J.ld = 2048; J.c0 = nt_ * 64; J.k0 = kc * 128; J.dst = (unsigned char*)C.Wpp(); J.ldd = 256; J.n0 = nt_ * 64; J.f8 = 0; J.scale = 1.f; }
    };
#define PRO_LOAD(buf, J) do { _Pragma("unroll") for (int q_ = 0; q_ < 4; ++q_) buf[q_] = *(const f32x4*)((J).src + (size_t)((J).k0 + (tid >> 4) + 32 * q_) * (J).ld + (J).c0 + (tid & 15) * 4); } while (0)
    { const int G = C.G; f32x4 b0[4], b1[4]; Job J0, J1, Jn; int par = 0;
      const int j0 = C.c; const bool has0 = j0 < E8, has1 = j0 + G < E8;
      if (has0) { decode(j0, J0); PRO_LOAD(b0, J0); }
      if (has1) { decode(j0 + G, J1); PRO_LOAD(b1, J1); }
      for (int j = j0; j < E8; j += G) {
          LAS float* t = tl + par * (64 * 129); par ^= 1;
          { const int cc = (tid & 15) * 4;
#pragma unroll
            for (int q_ = 0; q_ < 4; ++q_) { const int r = (tid >> 4) + 32 * q_; t[(cc + 0) * 129 + r] = b0[q_][0]; t[(cc + 1) * 129 + r] = b0[q_][1]; t[(cc + 2) * 129 + r] = b0[q_][2]; t[(cc + 3) * 129 + r] = b0[q_][3]; } }
          const Job Jc = J0;
          J0 = J1;
#pragma unroll
          for (int q_ = 0; q_ < 4; ++q_) b0[q_] = b1[q_];
          if (j + 2 * G < E8) { decode(j + 2 * G, Jn); J1 = Jn; PRO_LOAD(b1, J1); }
          __syncthreads();
          { const int n = tid >> 3, ks = (tid & 7) * 16; const LAS float* rp = t + n * 129 + ks; const float sc = Jc.scale;
            if (Jc.f8) { u32x4 w; w.x = pk4_fp8(rp[0] * sc, rp[1] * sc, rp[2] * sc, rp[3] * sc); w.y = pk4_fp8(rp[4] * sc, rp[5] * sc, rp[6] * sc, rp[7] * sc);
                w.z = pk4_fp8(rp[8] * sc, rp[9] * sc, rp[10] * sc, rp[11] * sc); w.w = pk4_fp8(rp[12] * sc, rp[13] * sc, rp[14] * sc, rp[15] * sc);
                *(u32x4*)(Jc.dst + (size_t)(Jc.n0 + n) * Jc.ldd + Jc.k0 + ks) = w; }
            else { const f32x4 a = (f32x4){rp[0], rp[1], rp[2], rp[3]}, b = (f32x4){rp[4], rp[5], rp[6], rp[7]}, c = (f32x4){rp[8], rp[9], rp[10], rp[11]}, d = (f32x4){rp[12], rp[13], rp[14], rp[15]};
                bf16_t* dp = (bf16_t*)Jc.dst + (size_t)(Jc.n0 + n) * Jc.ldd + Jc.k0 + ks; *(u32x4*)dp = pack8f(a, b); *(u32x4*)(dp + 8) = pack8f(c, d); } }
      }
      __syncthreads(); }
#undef PRO_LOAD
    { const float* rg = C.in(I_RGW) + (size_t)l * 2048 * 4; const float* re = C.in(I_REW) + (size_t)l * 2048 * 32;
      for (int i = C.c * NTHREADS + tid; i < 64 * 2048; i += C.G * NTHREADS) { const int n = i >> 11, k = i & 2047;
          const float v = (n < 4 ? rg[k * 4 + n] : (n < 36 ? re[k * 32 + (n - 4)] : 0.f)) * C.in(I_FNORM)[l * D + k];
          C.Wr()[(size_t)n * 2048 + k] = (bf16_t)(cvtpk(v, 0.f) & 0xffffu); } }
    { const float* ps = C.in(I_P) + (size_t)l * T * 256;
      for (size_t i = (size_t)(C.c * NTHREADS + tid) * 8; i < (size_t)T * 256; i += (size_t)C.G * NTHREADS * 8) {
          const f32x4 a = *(const f32x4*)(ps + i), b = *(const f32x4*)(ps + i + 4); *(u32x4*)(C.PB() + i) = pack8f(a, b); } }
    for (int it = C.c; it < 128; it += C.G) { const int kv = it >> 6, kc = it & 63; const float* pe = C.in(I_PE) + (size_t)(l * 2 + kv) * 4096 + kc * 64;
        const float* w1 = C.in(I_W1) + ((size_t)(l * 2 + kv) * 4096 + kc * 64) * 512; float s = 0.f;
        for (int k = 0; k < 64; ++k) s += pe[k] * w1[(size_t)k * 512 + tid];
        C.b1p()[(kv * 64 + kc) * 512 + tid] = s; }
    { unsigned zz = 0u; asm volatile("" : "+v"(zz));
      for (int i = C.c * NTHREADS + tid; i < 32 * LDZ / 8; i += C.G * NTHREADS) *(u32x4*)(C.Z() + (size_t)T * LDZ + (size_t)i * 8) = (u32x4){zz, zz, zz, zz}; }
}

template <int MODE, bool XBF>
__device__ __forceinline__ void phase_rmsnorm(const Ctx& C, const void* x, const float* g, bf16_t* h, unsigned char* h8, float* rsout = nullptr) {
    const int tid = otid(), wid = tid >> 6, lane = tid & 63;
    for (int row = C.c * 8 + wid; row < T; row += C.G * 8) {
        f32x4 v[8]; float s = 0.f;
#pragma unroll
        for (int j = 0; j < 8; ++j) {
            if constexpr (XBF) { const u32x2 a = *(const u32x2*)((const bf16_t*)x + (size_t)row * D + j * 256 + lane * 4); v[j] = (f32x4){bflo(a.x), bfhi(a.x), bflo(a.y), bfhi(a.y)}; }
            else v[j] = *(const f32x4*)((const float*)x + (size_t)row * D + j * 256 + lane * 4);
            s += v[j][0] * v[j][0] + v[j][1] * v[j][1] + v[j][2] * v[j][2] + v[j][3] * v[j][3]; }
        s = wave_sum(s); const float rs = 1.0f / sqrtf(s * (1.0f / D) + RMS_EPS);
        if (rsout && lane == 0) rsout[row] = rs;
#pragma unroll
        for (int j = 0; j < 8; ++j) { const f32x4 gv = *(const f32x4*)(g + j * 256 + lane * 4); const f32x4 y = v[j] * rs * gv;
            if constexpr (MODE & 2) *(unsigned*)(h8 + (size_t)row * D + j * 256 + lane * 4) = pk4_fp8(y[0], y[1], y[2], y[3]);
            if constexpr (MODE & 1) { u32x2 w; w.x = cvtpk(y[0], y[1]); w.y = cvtpk(y[2], y[3]); *(u32x2*)(h + (size_t)row * D + j * 256 + lane * 4) = w; } }
    }
}
__device__ __forceinline__ void phase_combine_norm(const Ctx& C, const float* g) {
    const int tid = otid(), wid = tid >> 6, lane = tid & 63;
    for (int row = C.c * 8 + wid; row < T; row += C.G * 8) {
        bf16_t* xr = C.XR() + (size_t)row * D; const unsigned char* y0 = (const unsigned char*)C.YB() + (size_t)(2 * row) * D; const unsigned char* y1 = y0 + D; f32x4 v[8]; float s = 0.f;
#pragma unroll
        for (int j = 0; j < 8; ++j) { const int col = j * 256 + lane * 4; { const u32x2 xw = *(const u32x2*)(xr + col); v[j] = (f32x4){bflo(xw.x), bfhi(xw.x), bflo(xw.y), bfhi(xw.y)}; } const unsigned a = *(const unsigned*)(y0 + col), b = *(const unsigned*)(y1 + col);
            const f32x2 al = __builtin_amdgcn_cvt_pk_f32_fp8(a, false), ah = __builtin_amdgcn_cvt_pk_f32_fp8(a, true), bl = __builtin_amdgcn_cvt_pk_f32_fp8(b, false), bh = __builtin_amdgcn_cvt_pk_f32_fp8(b, true);
            v[j][0] += al[0] + bl[0]; v[j][1] += al[1] + bl[1]; v[j][2] += ah[0] + bh[0]; v[j][3] += ah[1] + bh[1];
            { u32x2 w; w.x = cvtpk(v[j][0], v[j][1]); w.y = cvtpk(v[j][2], v[j][3]); *(u32x2*)(xr + col) = w; v[j] = (f32x4){bflo(w.x), bfhi(w.x), bflo(w.y), bfhi(w.y)}; }
            s += v[j][0] * v[j][0] + v[j][1] * v[j][1] + v[j][2] * v[j][2] + v[j][3] * v[j][3]; }
        s = wave_sum(s); const float rs = 1.0f / sqrtf(s * (1.0f / D) + RMS_EPS);
#pragma unroll
        for (int j = 0; j < 8; ++j) { const f32x4 gv = *(const f32x4*)(g + j * 256 + lane * 4); const f32x4 y = v[j] * rs * gv;
            *(unsigned*)(C.H8() + (size_t)row * D + j * 256 + lane * 4) = pk4_fp8(y[0], y[1], y[2], y[3]); }
    }
}
__device__ __forceinline__ void phase_final_norm(const Ctx& C, const float* g) {
    const int tid = otid(), wid = tid >> 6, lane = tid & 63;
    for (int row = C.c * 8 + wid; row < T; row += C.G * 8) {
        float* xr = C.x + (size_t)row * D; const bf16_t* xb = C.XR() + (size_t)row * D; f32x4 v[8]; float s = 0.f;
#pragma unroll
        for (int j = 0; j < 8; ++j) { const u32x2 a = *(const u32x2*)(xb + j * 256 + lane * 4); v[j] = (f32x4){bflo(a.x), bfhi(a.x), bflo(a.y), bfhi(a.y)}; s += v[j][0] * v[j][0] + v[j][1] * v[j][1] + v[j][2] * v[j][2] + v[j][3] * v[j][3]; }
        s = wave_sum(s); const float rs = 1.0f / sqrtf(s * (1.0f / D) + RMS_EPS);
#pragma unroll
        for (int j = 0; j < 8; ++j) { const f32x4 gv = *(const f32x4*)(g + j * 256 + lane * 4); *(f32x4*)(xr + j * 256 + lane * 4) = v[j] * rs * gv; }
    }
}

__device__ __forceinline__ void phase_conv(const Ctx& C) {
    const int l = C.layer, tid = otid(), wid = tid >> 6, lane = tid & 63;
    LAS bf16_t* ut = (LAS bf16_t*)(C.lds + LDS_STAGE);
    const float* cw = C.in(I_CCW) + (size_t)l * 31 * 1024; const float* cb = C.in(I_CCB) + (size_t)l * 1024;
    const float* lg = C.in(I_CLG) + (size_t)l * 1024; const float* lb = C.in(I_CLB) + (size_t)l * 1024; const float* sw = C.in(I_SCW) + (size_t)l * 3 * 1024;
    const int ntl = 0;
    for (int ti = 0; ti < (ntl ? ntl : (T / 32 - C.c + C.G - 1) / C.G); ++ti) {
        const int tile = ntl ? (C.c >= 128 ? (C.c - 128) * 3 + ti : 384 + C.c) : C.c + ti * C.G;
        const int tt0 = tile * 32, pos0 = tt0 & (SEQ - 1);
#pragma unroll 1
        for (int bt = 0; bt < 4; ++bt) { u32x4 av[4], gv8[4];
#pragma unroll
            for (int q = 0; q < 4; ++q) { const int it = tid + (bt * 4 + q) * NTHREADS, r = it >> 7, c8 = (it & 127) * 8; const bool ok = it < 62 * 128 && pos0 - 30 + r >= 0;
                const size_t rw = (size_t)(tt0 - 30 + (ok ? r : 30)); av[q] = *(const u32x4*)(C.Z() + rw * LDZ + ZCONF + c8); gv8[q] = *(const u32x4*)(C.GB() + rw * LDG + GCONF + c8); }
#pragma unroll
            for (int q = 0; q < 4; ++q) { const int it = tid + (bt * 4 + q) * NTHREADS, r = it >> 7, c8 = (it & 127) * 8; const bool ok = pos0 - 30 + r >= 0;
                if (it < 62 * 128) { const u32x4 a = av[q], gt = gv8[q]; u32x4 w;
                    w.x = cvtpk(bflo(a.x) * bflo(gt.x), bfhi(a.x) * bfhi(gt.x)); w.y = cvtpk(bflo(a.y) * bflo(gt.y), bfhi(a.y) * bfhi(gt.y));
                    w.z = cvtpk(bflo(a.z) * bflo(gt.z), bfhi(a.z) * bfhi(gt.z)); w.w = cvtpk(bflo(a.w) * bflo(gt.w), bfhi(a.w) * bfhi(gt.w));
                    if (!ok) { unsigned zz = 0u; asm volatile("" : "+v"(zz)); w = (u32x4){zz, zz, zz, zz}; }
                    *(LAS u32x4*)(ut + r * 1024 + c8) = w; } } }
        __syncthreads();
        const int c0 = lane * 16;
#define CH(j) (((j) >> 1) * 512 + lane * 8 + ((j) & 1) * 4)
        float acc[4][16];
#pragma unroll
        for (int j = 0; j < 4; ++j) { const f32x4 b = *(const f32x4*)(cb + CH(j));
#pragma unroll
            for (int i = 0; i < 4; ++i) { acc[i][j * 4 + 0] = b[0]; acc[i][j * 4 + 1] = b[1]; acc[i][j * 4 + 2] = b[2]; acc[i][j * 4 + 3] = b[3]; } }
        f32x4 wn[4];
#pragma unroll
        for (int j = 0; j < 4; ++j) wn[j] = *(const f32x4*)(cw + CH(j));
#pragma unroll 2
        for (int k = 0; k < 31; ++k) {
            float wv[16];
#pragma unroll
            for (int j = 0; j < 4; ++j) { wv[j * 4] = wn[j][0]; wv[j * 4 + 1] = wn[j][1]; wv[j * 4 + 2] = wn[j][2]; wv[j * 4 + 3] = wn[j][3]; }
            { const int kn = k + 1 < 31 ? k + 1 : 30;
#pragma unroll
              for (int j = 0; j < 4; ++j) wn[j] = *(const f32x4*)(cw + (size_t)kn * 1024 + CH(j)); }
#pragma unroll
            for (int i = 0; i < 4; ++i) { const LAS bf16_t* up = ut + (wid * 4 + i + k) * 1024 + lane * 8; const u32x4 u0 = *(const LAS u32x4*)up, u1 = *(const LAS u32x4*)(up + 512);
                acc[i][0] += wv[0] * bflo(u0.x); acc[i][1] += wv[1] * bfhi(u0.x); acc[i][2] += wv[2] * bflo(u0.y); acc[i][3] += wv[3] * bfhi(u0.y);
                acc[i][4] += wv[4] * bflo(u0.z); acc[i][5] += wv[5] * bfhi(u0.z); acc[i][6] += wv[6] * bflo(u0.w); acc[i][7] += wv[7] * bfhi(u0.w);
                acc[i][8] += wv[8] * bflo(u1.x); acc[i][9] += wv[9] * bfhi(u1.x); acc[i][10] += wv[10] * bflo(u1.y); acc[i][11] += wv[11] * bfhi(u1.y);
                acc[i][12] += wv[12] * bflo(u1.z); acc[i][13] += wv[13] * bfhi(u1.z); acc[i][14] += wv[14] * bflo(u1.w); acc[i][15] += wv[15] * bfhi(u1.w); }
        }
        float gv[16], bv[16];
#pragma unroll
        for (int j = 0; j < 4; ++j) { const f32x4 a = *(const f32x4*)(lg + CH(j)), b = *(const f32x4*)(lb + CH(j));
            gv[j * 4] = a[0]; gv[j * 4 + 1] = a[1]; gv[j * 4 + 2] = a[2]; gv[j * 4 + 3] = a[3]; bv[j * 4] = b[0]; bv[j * 4 + 1] = b[1]; bv[j * 4 + 2] = b[2]; bv[j * 4 + 3] = b[3]; }
#pragma unroll
        for (int i = 0; i < 4; ++i) { float s = 0.f;
#pragma unroll
            for (int j = 0; j < 16; ++j) s += acc[i][j];
            s = wave_sum(s); const float mean = s * (1.0f / 1024.0f); float q = 0.f;
#pragma unroll
            for (int j = 0; j < 16; ++j) { const float d = acc[i][j] - mean; q += d * d; }
            q = wave_sum(q); const float rs = 1.0f / sqrtf(q * (1.0f / 1024.0f) + RMS_EPS);
            float y[16];
#pragma unroll
            for (int j = 0; j < 16; ++j) y[j] = siluf_((acc[i][j] - mean) * rs * gv[j] + bv[j]);
            unsigned char* op = (unsigned char*)C.OB() + (size_t)(tt0 + wid * 4 + i) * 6144 + 2048 + lane * 8;
            u32x2 w0, w1; w0.x = pk4_fp8(y[0], y[1], y[2], y[3]); w0.y = pk4_fp8(y[4], y[5], y[6], y[7]); w1.x = pk4_fp8(y[8], y[9], y[10], y[11]); w1.y = pk4_fp8(y[12], y[13], y[14], y[15]);
            *(u32x2*)op = w0; *(u32x2*)(op + 512) = w1; }
#undef CH
        { float w3[3][16];
#pragma unroll
          for (int k = 0; k < 3; ++k)
#pragma unroll
              for (int j = 0; j < 4; ++j) { const f32x4 a = *(const f32x4*)(sw + k * 1024 + c0 + j * 4); w3[k][j * 4] = a[0]; w3[k][j * 4 + 1] = a[1]; w3[k][j * 4 + 2] = a[2]; w3[k][j * 4 + 3] = a[3]; }
          const int t0_ = tt0 + wid * 4, pos0_ = t0_ & (SEQ - 1); u32x4 cr[6][2];
#pragma unroll
          for (int r = 0; r < 6; ++r) { const bool ok = pos0_ - 2 + r >= 0; const bf16_t* zp = C.Z() + (size_t)(t0_ - 2 + (ok ? r : 2)) * LDZ + ZSC + 1024 + c0;
              cr[r][0] = *(const u32x4*)zp; cr[r][1] = *(const u32x4*)(zp + 8);
              if (!ok) { unsigned zz = 0u; asm volatile("" : "+v"(zz)); cr[r][0] = (u32x4){zz, zz, zz, zz}; cr[r][1] = (u32x4){zz, zz, zz, zz}; } }
#pragma unroll
          for (int i = 0; i < 4; ++i) { const int t = tt0 + wid * 4 + i; float a[16];
#pragma unroll
              for (int j = 0; j < 16; ++j) a[j] = 0.f;
#pragma unroll
              for (int k = 0; k < 3; ++k) { const u32x4 g0 = cr[i + k][0], g1 = cr[i + k][1];
                  a[0] += w3[k][0] * bflo(g0.x); a[1] += w3[k][1] * bfhi(g0.x); a[2] += w3[k][2] * bflo(g0.y); a[3] += w3[k][3] * bfhi(g0.y);
                  a[4] += w3[k][4] * bflo(g0.z); a[5] += w3[k][5] * bfhi(g0.z); a[6] += w3[k][6] * bflo(g0.w); a[7] += w3[k][7] * bfhi(g0.w);
                  a[8] += w3[k][8] * bflo(g1.x); a[9] += w3[k][9] * bfhi(g1.x); a[10] += w3[k][10] * bflo(g1.y); a[11] += w3[k][11] * bfhi(g1.y);
                  a[12] += w3[k][12] * bflo(g1.z); a[13] += w3[k][13] * bfhi(g1.z); a[14] += w3[k][14] * bflo(g1.w); a[15] += w3[k][15] * bfhi(g1.w); }
              const bf16_t* bp = C.Z() + (size_t)t * LDZ + ZSC + c0; const u32x4 b0 = *(const u32x4*)bp, b1 = *(const u32x4*)(bp + 8);
u32x4 w0, w1; w0.x = cvtpk(a[0] * bflo(b0.x), a[1] * bfhi(b0.x)); w0.y = cvtpk(a[2] * bflo(b0.y), a[3] * bfhi(b0.y)); w0.z = cvtpk(a[4] * bflo(b0.z), a[5] * bfhi(b0.z)); w0.w = cvtpk(a[6] * bflo(b0.w), a[7] * bfhi(b0.w));
              w1.x = cvtpk(a[8] * bflo(b1.x), a[9] * bfhi(b1.x)); w1.y = cvtpk(a[10] * bflo(b1.y), a[11] * bfhi(b1.y)); w1.z = cvtpk(a[12] * bflo(b1.z), a[13] * bfhi(b1.z)); w1.w = cvtpk(a[14] * bflo(b1.w), a[15] * bfhi(b1.w));
              bf16_t* op = C.OB() + (size_t)t * 3072 + 2048 + c0; *(u32x4*)op = w0; *(u32x4*)(op + 8) = w1; } }
        __syncthreads();
    }
}

using pg8::Unit;
#define EPI_BEGIN _Pragma("unroll") for (int ai = 0; ai < 2; ++ai) _Pragma("unroll") for (int m = 0; m < 4; ++m) { const int rl = ai * 128 + wr * 64 + m * 16 + fr;
#define EPI_END asm volatile("" ::: "memory"); __builtin_amdgcn_sched_barrier(0); }
struct PlainBase {
    static constexpr bool A_PER_UNIT = false, FP8 = false;
    const bf16_t* A; const bf16_t* Bt; int lda, ldb_, nM, nN, ntk, G, c;
    __device__ __forceinline__ bool next(int i, Unit& u) const { return pg8::static_unit(i * G + c, nM, nN, u); }
    __device__ __forceinline__ int nt(const Unit&) const { return ntk; }
    __device__ __forceinline__ const char* a_base(const Unit& u) const { return (const char*)(A + (size_t)u.pm * 256 * lda); }
    __device__ __forceinline__ unsigned a_off(const Unit&, int, int R, int Cc) const { return (unsigned)(R * lda + Cc) * 2u; }
    __device__ __forceinline__ size_t a_hofs() const { return (size_t)128 * lda * 2; }
    __device__ __forceinline__ size_t a_kofs(int kt) const { return (size_t)kt * 128; }
    __device__ __forceinline__ const char* b_base(const Unit& u) const { return (const char*)(Bt + (size_t)u.pn * 256 * ldb_); }
    __device__ __forceinline__ int ldb() const { return ldb_; }
};
template <bool F8>
struct ProbInT : PlainBase {
    static constexpr bool FP8 = F8;
    bf16_t* O; int ldo; bf16_t* O2; int ldo2, n1;
    __device__ __forceinline__ bool next(int i, Unit& u) const {
        if (!F8) return pg8::static_unit(i * G + c, nM, nN, u);
        if (G != 256 || nN != 38) return pg8::static_unit(i * G + (G - 1 - c), nM, nN, u);
        if (i < 8) return pg8::static_unit(i * 256 + c, nM, nN, u);
        if (c < 64 || i >= 10) return false;
        return pg8::static_unit(2048 + (i - 8) * 192 + (c - 64), nM, nN, u); }
    __device__ __forceinline__ void epi(const Acc& acc, const Unit& u, int wr, int wc, int fr, int fq) const {
        const bool second = F8 && u.pn >= n1;
        const int col0 = (second ? u.pn - n1 : u.pn) * 256 + wc * 32 + fq * 8; const bool sg = F8 ? (opaque_s0(1) != 0 && !second) : (opaque_s0(0) != 0 || u.pn == (ZG24 - ZCONF) / 256);
        bf16_t* Ob = second ? O2 : O; const int ldo_ = second ? ldo2 : ldo;
        const bool cxt = !F8 && u.pn >= (ZSC + 1024 - ZCONF) / 256 && u.pn < (ZG24 - ZCONF) / 256;
        const bool g8 = F8 && u.pn < GCONF / 256;
        EPI_BEGIN { bf16_t* rp = Ob + (size_t)(u.pm * 256 + rl) * ldo_ + col0;
            if (cxt) { *(u32x4*)(O + (size_t)(u.pm * 256 + rl) * ldo + (ZSC + 1024 - ZCONF) + (u.pn - (ZSC + 1024 - ZCONF) / 256) * 128 + wc * 32 + fq * 8) = pack8f(acc[ai][0][m][0] * acc[ai][1][m][0], acc[ai][0][m][1] * acc[ai][1][m][1]); }
            else
#pragma unroll
            for (int bj = 0; bj < 2; ++bj) { f32x4 v0 = acc[ai][bj][m][0], v1 = acc[ai][bj][m][1];
                if (sg) {
#pragma unroll
                    for (int j = 0; j < 4; ++j) { v0[j] = sigmoidf_(v0[j] * (F8 ? 1.0f / 64.0f : 1.0f)); v1[j] = sigmoidf_(v1[j] * (F8 ? 1.0f / 64.0f : 1.0f)); } }
                else if (F8) { v0 *= 1.0f / 64.0f; v1 *= 1.0f / 64.0f; }
                if (g8) { u32x2 w;
                    w.x = (unsigned)(v0[0] * 255.f + 0.5f) | ((unsigned)(v0[1] * 255.f + 0.5f) << 8) | ((unsigned)(v0[2] * 255.f + 0.5f) << 16) | ((unsigned)(v0[3] * 255.f + 0.5f) << 24);
                    w.y = (unsigned)(v1[0] * 255.f + 0.5f) | ((unsigned)(v1[1] * 255.f + 0.5f) << 8) | ((unsigned)(v1[2] * 255.f + 0.5f) << 16) | ((unsigned)(v1[3] * 255.f + 0.5f) << 24);
                    *(u32x2*)((unsigned char*)O + (size_t)(u.pm * 256 + rl) * (ldo * 2) + col0 + bj * 128) = w; }
                else *(u32x4*)(rp + bj * 128) = pack8f(v0, v1); } } EPI_END
    }
};
struct ProbC1 {
    static constexpr bool A_PER_UNIT = false; static constexpr int FP8 = 0;
    const bf16_t* Z; const bf16_t* Wc1; float* slab; int c;
    __device__ __forceinline__ bool next(int i, Unit& u) const { if (i > 0 || c >= 256) return false; u.aux = c & 7; u.pm = c >> 4; u.pn = (c >> 3) & 1; return true; }
    __device__ __forceinline__ int nt(const Unit&) const { return 8; }
    __device__ __forceinline__ const char* a_base(const Unit& u) const { const int kv = u.pm >> 3, bg = u.pm & 7, b = bg >> 1, g = bg & 1; return (const char*)(Z + (size_t)(b * SEQ + u.aux * 4) * LDZ + ZKV + kv * 256 + g * 128); }
    __device__ __forceinline__ unsigned a_off(const Unit&, int, int R, int Cc) const { return (unsigned)(R * 16 * LDZ + Cc) * 2u; }
    __device__ __forceinline__ size_t a_hofs() const { return (size_t)128 * 16 * LDZ * 2; }
    __device__ __forceinline__ size_t a_kofs(int kt) const { return ((size_t)(kt >> 1) * LDZ + (size_t)(kt & 1) * 64) * 2; }
    __device__ __forceinline__ const char* b_base(const Unit& u) const { return (const char*)(Wc1 + ((size_t)(u.pm >> 3) * 512 + (size_t)u.pn * 256) * 4096 + u.aux * 512); }
    __device__ __forceinline__ int ldb() const { return 4096; }
    __device__ __forceinline__ void epi(const Acc& acc, const Unit& u, int wr, int wc, int fr, int fq) const {
        const int col0 = u.pn * 256 + wc * 32 + fq * 8; float* sp = slab + (size_t)u.aux * 4096 * 512;
        EPI_BEGIN { float* rp = sp + (size_t)(u.pm * 256 + rl) * 512 + col0;
#pragma unroll
            for (int bj = 0; bj < 2; ++bj) { *(f32x4*)(rp + bj * 128) = acc[ai][bj][m][0]; *(f32x4*)(rp + bj * 128 + 4) = acc[ai][bj][m][1]; } } EPI_END
    }
};
__device__ __forceinline__ void phase_c1_reduce(const Ctx& C, const float* slab) {
    const int tid = otid();
    for (int it = C.c * NTHREADS + tid; it < 4096 * 64; it += C.G * NTHREADS) { const int row = it >> 6, c8 = (it & 63) * 8, kv = row >> 11;
        const float* sp = slab + (size_t)row * 512 + c8; const float* bp = C.b1() + kv * 512 + c8;
        f32x4 a = *(const f32x4*)bp, b = *(const f32x4*)(bp + 4);
#pragma unroll
        for (int ks = 0; ks < 8; ++ks) { a += *(const f32x4*)(sp + (size_t)ks * 4096 * 512); b += *(const f32x4*)(sp + (size_t)ks * 4096 * 512 + 4); }
#pragma unroll
        for (int j = 0; j < 4; ++j) { a[j] = gelu_tanh(a[j]); b[j] = gelu_tanh(b[j]); }
        *(u32x4*)(C.HID() + (size_t)row * 512 + c8) = pack8f(a, b); }
}
struct ProbC2 : PlainBase {
    bf16_t* KC; bf16_t* VC;
    __device__ __forceinline__ bool next(int i, Unit& u) const { if (i > 0 || c >= 16) return false; u.pm = c; u.pn = 0; u.aux = 0; return true; }
    __device__ __forceinline__ void epi(const Acc& acc, const Unit& u, int wr, int wc, int fr, int fq) const {
        const int kv = u.pm >> 3; bf16_t* dst = (kv ? VC : KC) + (size_t)(u.pm & 7) * 256 * 128 + wc * 32 + fq * 8;
        EPI_BEGIN { const f32x4 v0 = kv ? acc[ai][1][m][0] : acc[ai][0][m][0], v1 = kv ? acc[ai][1][m][1] : acc[ai][0][m][1]; *(u32x4*)(dst + (size_t)rl * 128) = pack8f(v0, v1); } EPI_END
    }
};
template <bool F8>
struct ProbBr {
    static constexpr bool A_PER_UNIT = false, FP8 = F8;
    const bf16_t* OB; const bf16_t* Wbr; const bf16_t* Z; bf16_t* MRG; int G, c;
    __device__ __forceinline__ bool next(int i, Unit& u) const { const int ui = F8 ? i >> 1 : i; if (!pg8::static_unit(ui * G + c, 64, 8, u)) return false; u.aux = F8 ? 1 - (i & 1) : 2; return true; }
    __device__ __forceinline__ int nt(const Unit&) const { return F8 ? 8 : 16; }
    __device__ __forceinline__ const char* a_base(const Unit& u) const { return (const char*)OB + (size_t)u.pm * 256 * 6144 + (F8 ? 3072 - u.aux * 1024 : 4096); }
    __device__ __forceinline__ unsigned a_off(const Unit&, int, int R, int Cc) const { return (unsigned)(R * 3072 + Cc) * 2u; }
    __device__ __forceinline__ size_t a_hofs() const { return (size_t)128 * 3072 * 2; }
    __device__ __forceinline__ size_t a_kofs(int kt) const { return (size_t)kt * 128; }
    __device__ __forceinline__ const char* b_base(const Unit& u) const { return (const char*)Wbr + (size_t)u.pn * 256 * 6144 + (F8 ? 3072 - u.aux * 1024 : 4096); }
    __device__ __forceinline__ int ldb() const { return 3072; }
    __device__ __forceinline__ void epi(const Acc& acc, const Unit& u, int wr, int wc, int fr, int fq) const {
        const int col0 = u.pn * 256 + wc * 32 + fq * 8; constexpr bool rmw = F8; const float sc = (F8 ? (u.aux ? 1.0f / 64.0f : 1.0f / 1024.0f) : 1.0f) * (1.0f / 255.0f);
        const unsigned char* gp0 = (const unsigned char*)Z + (size_t)(u.pm * 256 + wr * 64 + fr) * (LDG * 2) + u.aux * 2048 + col0;
        bf16_t* mp0 = MRG + (size_t)(u.pm * 256 + wr * 64 + fr) * 2048 + col0;
        u32x2 gw[2][2]; u32x4 pw[2][2];
#define BR_LOAD(r) do { const int ro_ = ((r) >> 2) * 128 + ((r) & 3) * 16; gw[(r) & 1][0] = *(const u32x2*)(gp0 + (size_t)ro_ * (LDG * 2)); gw[(r) & 1][1] = *(const u32x2*)(gp0 + (size_t)ro_ * (LDG * 2) + 128); \
        if (rmw) { pw[(r) & 1][0] = *(const u32x4*)(mp0 + (size_t)ro_ * 2048); pw[(r) & 1][1] = *(const u32x4*)(mp0 + (size_t)ro_ * 2048 + 128); } } while (0)
        BR_LOAD(0);
#pragma unroll
        for (int r = 0; r < 8; ++r) { const int ai = r >> 2, m = r & 3;
            if (r + 1 < 8) BR_LOAD(r + 1);
            bf16_t* mp = mp0 + (size_t)(ai * 128 + m * 16) * 2048;
#pragma unroll
            for (int bj = 0; bj < 2; ++bj) { const u32x2 g = gw[r & 1][bj]; f32x4 v0 = acc[ai][bj][m][0] * sc, v1 = acc[ai][bj][m][1] * sc;
                v0[0] *= (float)((g.x >> 0) & 0xffu); v0[1] *= (float)((g.x >> 8) & 0xffu); v0[2] *= (float)((g.x >> 16) & 0xffu); v0[3] *= (float)((g.x >> 24) & 0xffu);
                v1[0] *= (float)((g.y >> 0) & 0xffu); v1[1] *= (float)((g.y >> 8) & 0xffu); v1[2] *= (float)((g.y >> 16) & 0xffu); v1[3] *= (float)((g.y >> 24) & 0xffu);
                if (rmw) { const u32x4 q = pw[r & 1][bj];
                    v0[0] += bflo(q.x); v0[1] += bfhi(q.x); v0[2] += bflo(q.y); v0[3] += bfhi(q.y); v1[0] += bflo(q.z); v1[1] += bfhi(q.z); v1[2] += bflo(q.w); v1[3] += bfhi(q.w); }
                *(u32x4*)(mp + bj * 128) = pack8f(v0, v1); }
            asm volatile("" ::: "memory"); __builtin_amdgcn_sched_barrier(0); }
#undef BR_LOAD
    }
};
template <bool XBF>
struct ProbOut : PlainBase {
    const void* xin; bf16_t* xout;
    __device__ __forceinline__ void epi(const Acc& acc, const Unit& u, int wr, int wc, int fr, int fq) const {
        const size_t o0 = (size_t)(u.pm * 256 + wr * 64 + fr) * D + u.pn * 256 + wc * 32 + fq * 8;
        f32x4 xv[2][4]; u32x4 xb[2][2];
#define OUT_LOAD(r) do { const size_t o_ = o0 + (size_t)(((r) >> 2) * 128 + ((r) & 3) * 16) * D; \
        if constexpr (XBF) { xb[(r) & 1][0] = *(const u32x4*)((const bf16_t*)xin + o_); xb[(r) & 1][1] = *(const u32x4*)((const bf16_t*)xin + o_ + 128); } \
        else { xv[(r) & 1][0] = *(const f32x4*)((const float*)xin + o_); xv[(r) & 1][1] = *(const f32x4*)((const float*)xin + o_ + 4); \
               xv[(r) & 1][2] = *(const f32x4*)((const float*)xin + o_ + 128); xv[(r) & 1][3] = *(const f32x4*)((const float*)xin + o_ + 132); } } while (0)
        OUT_LOAD(0);
#pragma unroll
        for (int r = 0; r < 8; ++r) { const int ai = r >> 2, m = r & 3;
            if (r + 1 < 8) OUT_LOAD(r + 1);
            bf16_t* op = xout + o0 + (size_t)(ai * 128 + m * 16) * D;
#pragma unroll
            for (int bj = 0; bj < 2; ++bj) { f32x4 a, b;
                if constexpr (XBF) { const u32x4 w = xb[r & 1][bj]; a = (f32x4){bflo(w.x), bfhi(w.x), bflo(w.y), bfhi(w.y)}; b = (f32x4){bflo(w.z), bfhi(w.z), bflo(w.w), bfhi(w.w)}; }
                else { a = xv[r & 1][2 * bj]; b = xv[r & 1][2 * bj + 1]; }
                *(u32x4*)(op + bj * 128) = pack8f(a + acc[ai][bj][m][0], b + acc[ai][bj][m][1]); }
            asm volatile("" ::: "memory"); __builtin_amdgcn_sched_barrier(0); }
#undef OUT_LOAD
    }
};
struct ProbRt : PlainBase {
    float* LOG;
    __device__ __forceinline__ bool next(int i, Unit& u) const { if (i > 0 || c >= 256) return false; u.pm = c >> 2; u.pn = 0; u.aux = c & 3; return true; }
    __device__ __forceinline__ const char* a_base(const Unit& u) const { return (const char*)(A + (size_t)u.pm * 256 * lda + u.aux * 512); }
    __device__ __forceinline__ const char* b_base(const Unit& u) const { return (const char*)(Bt + u.aux * 512); }
    __device__ __forceinline__ void epi(const Acc& acc, const Unit& u, int wr, int wc, int fr, int fq) const {
        if (wc >= 2) return; const int col0 = wc * 32 + fq * 8; float* sl = LOG + (size_t)u.aux * T * 64;
        EPI_BEGIN { float* lp = sl + (size_t)(u.pm * 256 + rl) * 64 + col0; *(f32x4*)lp = acc[ai][0][m][0]; *(f32x4*)(lp + 4) = acc[ai][0][m][1]; } EPI_END
    }
};
struct ProbUp {
    static constexpr bool A_PER_UNIT = true, FP8 = true;
    const unsigned char* H8; const unsigned char* Wgu; unsigned char* HE; const int* stok; const int* texp; int ntile, G, c;
    __device__ __forceinline__ bool next(int i, Unit& u) const { const int L = i * G + c; if (L >= ntile * 4) return false; u.pm = L >> 2; u.pn = L & 3; u.aux = __builtin_amdgcn_readfirstlane(texp[u.pm]); return true; }
    __device__ __forceinline__ int nt(const Unit&) const { return 16; }
    __device__ __forceinline__ const char* a_base(const Unit&) const { return (const char*)H8; }
    __device__ __forceinline__ unsigned a_off(const Unit& u, int h, int R, int Cc) const { return (unsigned)(stok[u.pm * 256 + h * 128 + R] * 1024 + Cc) * 2u; }
    __device__ __forceinline__ size_t a_hofs() const { return 0; }
    __device__ __forceinline__ size_t a_kofs(int kt) const { return (size_t)kt * 128; }
    __device__ __forceinline__ const char* b_base(const Unit& u) const { return (const char*)(Wgu + ((size_t)u.aux * 1024 + (size_t)u.pn * 256) * 2048); }
    __device__ __forceinline__ int ldb() const { return 1024; }
    __device__ __forceinline__ void epi(const Acc& acc, const Unit& u, int wr, int wc, int fr, int fq) const {
        const int col0 = u.pn * 128 + wc * 32 + fq * 8;
        EPI_BEGIN { f32x4 v0, v1;
#pragma unroll
            for (int j = 0; j < 4; ++j) { v0[j] = siluf_(acc[ai][0][m][0][j] * (1.0f / 64.0f)) * (acc[ai][1][m][0][j] * (1.0f / 64.0f)); v1[j] = siluf_(acc[ai][0][m][1][j] * (1.0f / 64.0f)) * (acc[ai][1][m][1][j] * (1.0f / 64.0f)); }
            u32x2 w; w.x = pk4_fp8(v0[0], v0[1], v0[2], v0[3]); w.y = pk4_fp8(v1[0], v1[1], v1[2], v1[3]);
            *(u32x2*)(HE + (size_t)(u.pm * 256 + rl) * 512 + col0) = w; } EPI_END
    }
};
struct ProbDn {
    static constexpr bool A_PER_UNIT = false, FP8 = true;
    const unsigned char* HE; const unsigned char* Wd; bf16_t* YB; const int* sdst; const float* sw; const int* texp; int ntile, G, c;
    __device__ __forceinline__ bool next(int i, Unit& u) const { const int L = i * G + c; if (L >= ntile * 8) return false; u.pm = L >> 3; u.pn = L & 7; u.aux = __builtin_amdgcn_readfirstlane(texp[u.pm]); return true; }
    __device__ __forceinline__ int nt(const Unit&) const { return 4; }
    __device__ __forceinline__ const char* a_base(const Unit& u) const { return (const char*)(HE + (size_t)u.pm * 256 * 512); }
    __device__ __forceinline__ unsigned a_off(const Unit&, int, int R, int Cc) const { return (unsigned)(R * 256 + Cc) * 2u; }
    __device__ __forceinline__ size_t a_hofs() const { return (size_t)128 * 512; }
    __device__ __forceinline__ size_t a_kofs(int kt) const { return (size_t)kt * 128; }
    __device__ __forceinline__ const char* b_base(const Unit& u) const { return (const char*)(Wd + ((size_t)u.aux * 2048 + (size_t)u.pn * 256) * 512); }
    __device__ __forceinline__ int ldb() const { return 256; }
    __device__ __forceinline__ void epi(const Acc& acc, const Unit& u, int wr, int wc, int fr, int fq) const {
        const int col0 = u.pn * 256 + wc * 32 + fq * 8;
        int dsts[8]; float ws[8];
#pragma unroll
        for (int r = 0; r < 8; ++r) { const int slot = u.pm * 256 + (r >> 2) * 128 + wr * 64 + (r & 3) * 16 + fr; dsts[r] = sdst[slot]; ws[r] = sw[slot] * (1.0f / 32.0f); }
        EPI_BEGIN { const int dst = dsts[ai * 4 + m]; const float w = ws[ai * 4 + m]; (void)rl;
            unsigned char* yp = (unsigned char*)YB + (size_t)dst * 2048 + col0;
#pragma unroll
            for (int bj = 0; bj < 2; ++bj) { const f32x4 a = acc[ai][bj][m][0] * w, b = acc[ai][bj][m][1] * w; u32x2 q; q.x = pk4_fp8(a[0], a[1], a[2], a[3]); q.y = pk4_fp8(b[0], b[1], b[2], b[3]); *(u32x2*)(yp + bj * 128) = q; } } EPI_END
    }
};
struct ProbPp : PlainBase {
    bf16_t* PP;
    __device__ __forceinline__ void epi(const Acc& acc, const Unit& u, int wr, int wc, int fr, int fq) const {
        const int col0 = u.pn * 256 + wc * 32 + fq * 8;
        EPI_BEGIN { bf16_t* rp = PP + (size_t)(u.pm * 256 + rl) * 2048 + col0;
#pragma unroll
            for (int bj = 0; bj < 2; ++bj) *(u32x4*)(rp + bj * 128) = pack8f(acc[ai][bj][m][0], acc[ai][bj][m][1]); } EPI_END
    }
};
struct ProbPg : PlainBase {
    static constexpr bool FP8 = true;
    const bf16_t* PP; bf16_t* x;
    __device__ __forceinline__ void epi(const Acc& acc, const Unit& u, int wr, int wc, int fr, int fq) const {
        const size_t o0 = (size_t)(u.pm * 256 + wr * 64 + fr) * D + u.pn * 256 + wc * 32 + fq * 8;
        u32x4 xb[2][2], pv[2][2];
#define PG_LOAD(r) do { const size_t o_ = o0 + (size_t)(((r) >> 2) * 128 + ((r) & 3) * 16) * D; xb[(r) & 1][0] = *(const u32x4*)(x + o_); xb[(r) & 1][1] = *(const u32x4*)(x + o_ + 128); \
        pv[(r) & 1][0] = *(const u32x4*)(PP + o_); pv[(r) & 1][1] = *(const u32x4*)(PP + o_ + 128); } while (0)
        PG_LOAD(0);
#pragma unroll
        for (int r = 0; r < 8; ++r) { const int ai = r >> 2, m = r & 3;
            if (r + 1 < 8) PG_LOAD(r + 1);
            bf16_t* op = x + o0 + (size_t)(ai * 128 + m * 16) * D;
#pragma unroll
            for (int bj = 0; bj < 2; ++bj) { const u32x4 pw = pv[r & 1][bj], xw = xb[r & 1][bj]; f32x4 a = (f32x4){bflo(xw.x), bfhi(xw.x), bflo(xw.y), bfhi(xw.y)}, b = (f32x4){bflo(xw.z), bfhi(xw.z), bflo(xw.w), bfhi(xw.w)};
                const f32x4 g0 = acc[ai][bj][m][0] * (1.0f / 64.0f), g1 = acc[ai][bj][m][1] * (1.0f / 64.0f);
                a[0] += sigmoidf_(g0[0]) * bflo(pw.x); a[1] += sigmoidf_(g0[1]) * bfhi(pw.x); a[2] += sigmoidf_(g0[2]) * bflo(pw.y); a[3] += sigmoidf_(g0[3]) * bfhi(pw.y);
                b[0] += sigmoidf_(g1[0]) * bflo(pw.z); b[1] += sigmoidf_(g1[1]) * bfhi(pw.z); b[2] += sigmoidf_(g1[2]) * bflo(pw.w); b[3] += sigmoidf_(g1[3]) * bfhi(pw.w);
                *(u32x4*)(op + bj * 128) = pack8f(a, b); }
            asm volatile("" ::: "memory"); __builtin_amdgcn_sched_barrier(0); }
#undef PG_LOAD
    }
};

__device__ __forceinline__ void phase_route(const Ctx& C) {
    const int l = C.layer, tid = otid();
    const float* rgb = C.in(I_RGB) + l * 4; const float* reb = C.in(I_REB) + l * 32; unsigned* cnt = C.ctl() + CW_CNT + l * 64;
    for (int i = C.c * NTHREADS + tid; i < NSLOT; i += C.G * NTHREADS) { C.stok()[i] = 0; C.sdst()[i] = 2 * T; C.sw()[i] = 0.f; }
    LAS unsigned* lc = (LAS unsigned*)(C.lds + LDS_MISC + 512);
    if (tid < 32) lc[tid] = 0u;
    __syncthreads();
    for (int t = C.c * NTHREADS + tid; t < T; t += C.G * NTHREADS) {
        const float* lp = C.LOG() + (size_t)t * 64; float gl[4]; const float rs = C.RS()[t];
#pragma unroll
        for (int j = 0; j < 4; ++j) gl[j] = ((lp[j] + lp[j + T * 64]) + (lp[j + 2 * T * 64] + lp[j + 3 * T * 64])) * rs + rgb[j];
        int grp = 0; float gm = gl[0];
#pragma unroll
        for (int j = 1; j < 4; ++j) if (gl[j] > gm) { gm = gl[j]; grp = j; }
        float gs = 0.f;
#pragma unroll
        for (int j = 0; j < 4; ++j) gs += __expf(gl[j] - gm);
        const float gw = 1.0f / gs;
        float el[8];
#pragma unroll
        for (int j = 0; j < 8; ++j) { const float* q_ = lp + 4 + grp * 8 + j; el[j] = ((q_[0] + q_[T * 64]) + (q_[2 * T * 64] + q_[3 * T * 64])) * rs + reb[grp * 8 + j]; }
        int i0 = 0; float m0 = el[0];
#pragma unroll
        for (int j = 1; j < 8; ++j) if (el[j] > m0) { m0 = el[j]; i0 = j; }
        int i1 = -1; float m1 = -3.0e38f;
#pragma unroll
        for (int j = 0; j < 8; ++j) if (j != i0 && el[j] > m1) { m1 = el[j]; i1 = j; }
        const float e1 = __expf(m1 - m0), w0 = gw / (1.0f + e1), w1 = gw * e1 / (1.0f + e1);
        const int ex0 = grp * 8 + i0, ex1 = grp * 8 + i1;
        const unsigned r0 = __hip_atomic_fetch_add(lc + ex0, 1u, __ATOMIC_RELAXED, __HIP_MEMORY_SCOPE_WORKGROUP), r1 = __hip_atomic_fetch_add(lc + ex1, 1u, __ATOMIC_RELAXED, __HIP_MEMORY_SCOPE_WORKGROUP);
        __syncthreads();
        if (tid < 32) { const unsigned n = lc[tid]; lc[32 + tid] = n ? atomicAdd(cnt + tid, n) : 0u; lc[tid] = 0u; }
        __syncthreads();
        const int p0 = (int)(lc[32 + ex0] + r0), p1 = (int)(lc[32 + ex1] + r1);
        __syncthreads();
        C.toke()[2 * t] = ex0; C.toke()[2 * t + 1] = ex1; C.tokp()[2 * t] = p0; C.tokp()[2 * t + 1] = p1; C.tokw()[2 * t] = w0; C.tokw()[2 * t + 1] = w1;
    }
}
__device__ __forceinline__ void phase_slots(const Ctx& C) {
    const int l = C.layer, tid = otid(); const unsigned* cnt = C.ctl() + CW_CNT + l * 64;
    LAS int* offs = (LAS int*)(C.lds + LDS_MISC);
    if (tid == 0) { int o = 0; for (int e = 0; e < 32; ++e) { offs[e] = o; o += ((int)__hip_atomic_load(cnt + e, __ATOMIC_RELAXED, __HIP_MEMORY_SCOPE_AGENT) + 255) >> 8; } offs[32] = o;
        if (C.c == 0) { for (int e = 0; e < 32; ++e) for (int r = offs[e]; r < offs[e + 1]; ++r) C.texp()[r] = e; C.ctl()[CW_NTILE + l] = (unsigned)o; } }
    __syncthreads();
    for (int i = C.c * NTHREADS + tid; i < 2 * T; i += C.G * NTHREADS) { const int e = C.toke()[i], slot = offs[e] * 256 + C.tokp()[i]; C.stok()[slot] = i >> 1; C.sdst()[slot] = i; C.sw()[slot] = C.tokw()[i]; }
    __syncthreads();
}

namespace at {
constexpr int SHM = 16384;
constexpr int L_V = 0, L_K = 32768, L_WS = 65536, L_TBL = L_WS + 2048, L_IMP = L_TBL + 2048, L_SELB = L_IMP + 16384, L_WUN = L_SELB + 512, L_TL = L_WUN + 64, L_OST = L_TL + 512  , L_END = L_OST + 8 * 4352;
static_assert(L_OST % 16 == 0 && L_END <= 131072, "attention LDS layout");
constexpr float C2 = 0.08838834764831845f * LOG2E;
#define KSWZ(row, colB) ((row) * 256 + ((colB) ^ (((row) & 7) << 4)))
__device__ __forceinline__ int v_st(int k, int c) { const int kk = (k & ~0xC) | ((k & 4) << 1) | ((k & 8) >> 1); return ((kk >> 3) * 4 + (c >> 5)) * 512 + ((kk & 7) * 32 + (c & 31)) * 2; }
__device__ __forceinline__ int v_rd_base(int lane) { return ((lane & 3) << 3) | (((lane >> 2) & 3) << 6) | (((lane >> 4) & 1) << 5) | (((lane >> 5) & 1) << 8); }
constexpr int v_rd_off(int d0, int ks, int half) { return d0 * 512 + ks * 4096 + half * 2048; }
__device__ __forceinline__ int t5_bucket(int n) {
    if (n < 16) return n;
    const int th[16] = {16, 19, 21, 24, 27, 31, 35, 40, 46, 52, 59, 67, 77, 87, 99, 113};
    int b = 16;
#pragma unroll
    for (int i = 1; i < 16; ++i) b += (n >= th[i]) ? 1 : 0;
    return b;
}
enum { M_CMP1 = 0, M_CMP2 = 1, M_SEL = 2, M_WIN = 3 };
struct St {
    bf16x8 qr[8]; f32x16 o[4]; float m, l, rl, bfar; int tq; unsigned mlo, mhi;
};
template <int KB>
__device__ __forceinline__ void qkt(f32x16& p0, f32x16& p1, const LAS char* K_lds, int r32, int hi, const bf16x8* qr) {
    p0 = f32x16{}; p1 = f32x16{};
    const LAS char* kb[4];
#pragma unroll
    for (int dd = 0; dd < 4; ++dd) kb[dd] = K_lds + KB * SHM + KSWZ(r32, (dd * 16 + hi * 8) * 2);
#pragma unroll
    for (int d0 = 0; d0 < 8; ++d0) { const LAS char* a = kb[d0 & 3] + (d0 >> 2) * 128;
        const bf16x8 b0 = *reinterpret_cast<const LAS bf16x8*>(a);
        const bf16x8 b1 = *reinterpret_cast<const LAS bf16x8*>(a + 32 * 256);
        p0 = __builtin_amdgcn_mfma_f32_32x32x16_bf16(b0, qr[d0], p0, 0, 0, 0);
        p1 = __builtin_amdgcn_mfma_f32_32x32x16_bf16(b1, qr[d0], p1, 0, 0, 0); }
}
template <int VB>
__device__ __forceinline__ void pv_tile(f32x16* o, int vb0, bf16x8 pa0, bf16x8 pa1, bf16x8 pa2, bf16x8 pa3) {
#define TRRD(dst, off) asm volatile("ds_read_b64_tr_b16 %0, %1 offset:%2" : "=&v"(dst) : "v"(vb0), "i"(off) : "memory")
#define PV_D0(d0) do { s16x4 l0, l1, l2, l3, h0, h1, h2, h3; constexpr int b_ = VB * SHM + v_rd_off(d0, 0, 0); \
        TRRD(l0, b_); TRRD(h0, b_ + 2048); TRRD(l1, b_ + 4096); TRRD(h1, b_ + 6144); TRRD(l2, b_ + 8192); TRRD(h2, b_ + 10240); TRRD(l3, b_ + 12288); TRRD(h3, b_ + 14336); \
        asm volatile("s_waitcnt lgkmcnt(0)" ::: "memory"); __builtin_amdgcn_sched_barrier(0); \
        o[d0] = __builtin_amdgcn_mfma_f32_32x32x16_bf16(pa0, (bf16x8){l0[0], l0[1], l0[2], l0[3], h0[0], h0[1], h0[2], h0[3]}, o[d0], 0, 0, 0); \
        o[d0] = __builtin_amdgcn_mfma_f32_32x32x16_bf16(pa1, (bf16x8){l1[0], l1[1], l1[2], l1[3], h1[0], h1[1], h1[2], h1[3]}, o[d0], 0, 0, 0); \
        o[d0] = __builtin_amdgcn_mfma_f32_32x32x16_bf16(pa2, (bf16x8){l2[0], l2[1], l2[2], l2[3], h2[0], h2[1], h2[2], h2[3]}, o[d0], 0, 0, 0); \
        o[d0] = __builtin_amdgcn_mfma_f32_32x32x16_bf16(pa3, (bf16x8){l3[0], l3[1], l3[2], l3[3], h3[0], h3[1], h3[2], h3[3]}, o[d0], 0, 0, 0); } while (0)
    PV_D0(0); PV_D0(1); PV_D0(2); PV_D0(3);
#undef PV_D0
#undef TRRD
}
__device__ __forceinline__ float swapmax(float v) { auto rr = __builtin_amdgcn_permlane32_swap(__float_as_uint(v), __float_as_uint(v), false, false); return fmaxf(__uint_as_float(rr[0]), __uint_as_float(rr[1])); }
__device__ __forceinline__ float swapsum(float v) { auto rr = __builtin_amdgcn_permlane32_swap(__float_as_uint(v), __float_as_uint(v), false, false); return __uint_as_float(rr[0]) + __uint_as_float(rr[1]); }
#define PK4(P, B_, OUT) do { const unsigned a0_ = cvtpk(P[B_ + 0], P[B_ + 1]), a1_ = cvtpk(P[B_ + 2], P[B_ + 3]), b0_ = cvtpk(P[B_ + 4], P[B_ + 5]), b1_ = cvtpk(P[B_ + 6], P[B_ + 7]); \
        auto r0_ = __builtin_amdgcn_permlane32_swap(a0_, b0_, false, false); auto r1_ = __builtin_amdgcn_permlane32_swap(a1_, b1_, false, false); \
        u32x4 w_ = {r0_[0], r1_[0], r0_[1], r1_[1]}; OUT = *reinterpret_cast<bf16x8*>(&w_); } while (0)

template <int MODE, int BUF>
__device__ __forceinline__ void tile_body(St& S, LAS char* L, int row0, int qb, int wid, int r32, int hi, int vb0) {
    const float NEG = -__builtin_inff();
    const int tl = r32 >> 2, hl = r32 & 3;
    f32x16 p0, p1;
    qkt<BUF>(p0, p1, L + L_K, r32, hi, S.qr);
    const LAS float* tb = (const LAS float*)(L + L_TBL) + hl * 128;
    bool fastp = false; float beff = 0.f;
    if constexpr (MODE == M_CMP1 || MODE == M_CMP2) {
        const int dq = S.tq - 31 - 16 * (row0 + 4 * hi);
        if (qb * 64 - 31 - 16 * (row0 + 63) >= 127) {
#pragma unroll
            for (int r = 0; r < 16; ++r) { p0[r] = fmaf(p0[r], C2, S.bfar); p1[r] = fmaf(p1[r], C2, S.bfar); }
        } else
#pragma unroll
        for (int r = 0; r < 16; ++r) { const int c = (r & 3) + 8 * (r >> 2);
            { const int d = dq - 16 * c; const int ix = d < 0 ? 0 : (d > 127 ? 127 : d); const float x = fmaf(p0[r], C2, tb[ix]); p0[r] = d >= 0 ? x : NEG; }
            { const int d = dq - 16 * (c + 32); const int ix = d < 0 ? 0 : (d > 127 ? 127 : d); const float x = fmaf(p1[r], C2, tb[ix]); p1[r] = d >= 0 ? x : NEG; } }
    } else {
        const int kpos0 = row0 & (SEQ - 1), j = kpos0 >> 6; const int dq = S.tq - kpos0 - 4 * hi;
        const bool near = j >= qb - 2;
        fastp = !near && !(MODE == M_WIN && j == qb - 8);
        if (MODE == M_SEL) { const bool sel_ = (j < 32 ? (S.mlo >> j) : (S.mhi >> (j - 32))) & 1u; beff = sel_ ? S.bfar : NEG; } else beff = S.bfar;
        if (fastp) { }
        else if (near) {
#pragma unroll
            for (int r = 0; r < 16; ++r) { const int c = (r & 3) + 8 * (r >> 2);
                { const int d = dq - c; const int ix = d < 0 ? 0 : (d > 127 ? 127 : d); p0[r] = fmaf(p0[r], C2, tb[ix]); }
                { const int d = dq - c - 32; const int ix = d < 0 ? 0 : (d > 127 ? 127 : d); p1[r] = fmaf(p1[r], C2, tb[ix]); } }
        } else {
#pragma unroll
            for (int r = 0; r < 16; ++r) { p0[r] = fmaf(p0[r], C2, S.bfar); p1[r] = fmaf(p1[r], C2, S.bfar); }
        }
        if constexpr (MODE == M_WIN) {
            if (j == qb || j == qb - 8) {
#pragma unroll
                for (int r = 0; r < 16; ++r) { const int c = (r & 3) + 8 * (r >> 2);
                    if ((unsigned)(dq - c) >= 512u) p0[r] = NEG;
                    if ((unsigned)(dq - c - 32) >= 512u) p1[r] = NEG; }
            }
        } else {
            const bool sel = (j < 32 ? (S.mlo >> j) : (S.mhi >> (j - 32))) & 1u;
            if (j == qb) {
#pragma unroll
                for (int r = 0; r < 16; ++r) { const int c = (r & 3) + 8 * (r >> 2);
                    if (dq - c < 0) p0[r] = NEG;
                    if (dq - c - 32 < 0) p1[r] = NEG; }
            }
            if (!sel && !fastp) {
#pragma unroll
                for (int r = 0; r < 16; ++r) { p0[r] = NEG; p1[r] = NEG; }
            }
        }
    }
    if constexpr (MODE == M_CMP1) {
        float pmax = p0[0];
#pragma unroll
        for (int r = 1; r < 16; ++r) pmax = fmaxf(pmax, p0[r]);
#pragma unroll
        for (int r = 0; r < 16; ++r) pmax = fmaxf(pmax, p1[r]);
        pmax = swapmax(pmax);
        const float mn = fmaxf(S.m, pmax), alpha = __builtin_amdgcn_exp2f(S.m - mn); S.m = mn;
        float ps = 0.f;
#pragma unroll
        for (int r = 0; r < 16; ++r) ps += __builtin_amdgcn_exp2f(p0[r] - mn) + __builtin_amdgcn_exp2f(p1[r] - mn);
        ps = swapsum(ps); S.l = S.l * alpha + ps;
    } else if constexpr (MODE == M_CMP2) {
#pragma unroll
        for (int r = 0; r < 16; ++r) { p0[r] = __builtin_amdgcn_exp2f(p0[r] - S.m) * S.rl; p1[r] = __builtin_amdgcn_exp2f(p1[r] - S.m) * S.rl; }
        LAS float* imp = (LAS float*)(L + L_IMP) + (wid * 8 + tl) * 64;
#pragma unroll
        for (int q = 0; q < 8; ++q) { const int rb = (q & 3) * 4; float s4, last;
            if (q < 4) { s4 = (p0[rb] + p0[rb + 1]) + (p0[rb + 2] + p0[rb + 3]); last = p0[rb + 3]; } else { s4 = (p1[rb] + p1[rb + 1]) + (p1[rb + 2] + p1[rb + 3]); last = p1[rb + 3]; }
            s4 += __shfl_xor(s4, 1); s4 += __shfl_xor(s4, 2); last += __shfl_xor(last, 1); last += __shfl_xor(last, 2);
            const int n = (row0 >> 2) + 2 * (q & 3) + hi + 8 * (q >> 2);
            if (hl == 0 && n < 64) { __hip_atomic_fetch_add(imp + n, s4, __ATOMIC_RELAXED, __HIP_MEMORY_SCOPE_WORKGROUP);
                if (n + 1 < 64) __hip_atomic_fetch_add(imp + n + 1, last, __ATOMIC_RELAXED, __HIP_MEMORY_SCOPE_WORKGROUP); } }
        bf16x8 pa0, pa1, pa2, pa3; PK4(p0, 0, pa0); PK4(p0, 8, pa1); PK4(p1, 0, pa2); PK4(p1, 8, pa3);
        pv_tile<BUF>(S.o, vb0, pa0, pa1, pa2, pa3);
    } else {
        float pmax = p0[0];
#pragma unroll
        for (int r = 1; r < 16; ++r) pmax = fmaxf(pmax, p0[r]);
#pragma unroll
        for (int r = 0; r < 16; ++r) pmax = fmaxf(pmax, p1[r]);
        pmax = swapmax(pmax);
        if (fastp) pmax = fmaf(pmax, C2, beff);
        float mn, alpha;
        if (__all(pmax - S.m <= 11.5f)) { mn = S.m; alpha = 1.f; }
        else { mn = fmaxf(S.m, pmax); alpha = __builtin_amdgcn_exp2f(S.m - mn); S.m = mn; }
        float ps = 0.f;
        if (fastp) { const float off = beff - mn;
#pragma unroll
            for (int r = 0; r < 16; ++r) { p0[r] = __builtin_amdgcn_exp2f(fmaf(p0[r], C2, off)); p1[r] = __builtin_amdgcn_exp2f(fmaf(p1[r], C2, off)); ps += p0[r] + p1[r]; }
        } else {
#pragma unroll
            for (int r = 0; r < 16; ++r) { p0[r] = __builtin_amdgcn_exp2f(p0[r] - mn); p1[r] = __builtin_amdgcn_exp2f(p1[r] - mn); ps += p0[r] + p1[r]; }
        }
        ps = swapsum(ps); S.l = S.l * alpha + ps;
        bf16x8 pa0, pa1, pa2, pa3; PK4(p0, 0, pa0); PK4(p0, 8, pa1); PK4(p1, 0, pa2); PK4(p1, 8, pa3);
        if (__any(alpha < 1.f)) {
            LAS float* al = (LAS float*)(L + L_WS) + wid * 64;
            if (hi == 0) al[r32] = alpha;
            asm volatile("s_waitcnt lgkmcnt(0)" ::: "memory");
#pragma unroll
            for (int g4 = 0; g4 < 4; ++g4) { const f32x4 a = *(const LAS f32x4*)(al + 8 * g4 + 4 * hi);
#pragma unroll
                for (int d = 0; d < 4; ++d) { S.o[d][4 * g4] *= a[0]; S.o[d][4 * g4 + 1] *= a[1]; S.o[d][4 * g4 + 2] *= a[2]; S.o[d][4 * g4 + 3] *= a[3]; } }
        }
        pv_tile<BUF>(S.o, vb0, pa0, pa1, pa2, pa3);
    }
}
struct RowSeq { int base, step; const LAS int* list; };
__device__ __forceinline__ int row_of(const RowSeq& q, int i) { return q.list ? __builtin_amdgcn_readfirstlane(q.list[i]) : q.base + q.step * i; }
template <int MODE>
__device__ __forceinline__ void attn_loop(St& S, LAS char* L, int n, const RowSeq& seq, const bf16_t* Kp, const bf16_t* Vp, int ld, int qb) {
    const int tid = otid(), wid = __builtin_amdgcn_readfirstlane(tid >> 6), lane = tid & 63, r32 = lane & 31, hi = lane >> 5;
    const int sr = tid >> 4, sc = (tid & 15) * 8, kws = KSWZ(sr, sc * 2), vst0 = v_st(sr, sc), vst1 = v_st(32 + sr, sc);
    const int vb0 = (int)(size_t)(L + L_V) + v_rd_base(lane);
    bf16x8 st_k0, st_k1, st_v0, st_v1;
#define AT_LOAD(r0) do { const size_t o_ = (size_t)((r0) + sr) * ld + sc; st_k0 = *(const bf16x8*)(Kp + o_); st_k1 = *(const bf16x8*)(Kp + o_ + (size_t)32 * ld); st_v0 = *(const bf16x8*)(Vp + o_); st_v1 = *(const bf16x8*)(Vp + o_ + (size_t)32 * ld); } while (0)
#define AT_WRITE(bf) do { *(LAS bf16x8*)(L + L_K + (bf) * SHM + kws) = st_k0; *(LAS bf16x8*)(L + L_K + (bf) * SHM + kws + 32 * 256) = st_k1; \
                          *(LAS bf16x8*)(L + L_V + (bf) * SHM + vst0) = st_v0; *(LAS bf16x8*)(L + L_V + (bf) * SHM + vst1) = st_v1; } while (0)
    if (n <= 0) return;
    AT_LOAD(row_of(seq, 0)); AT_WRITE(0); if (n > 1) AT_LOAD(row_of(seq, 1));
    __syncthreads();
    for (int i = 0; i < n; i += 2) {
        tile_body<MODE, 0>(S, L, row_of(seq, i), qb, wid, r32, hi, vb0);
        if (i + 1 < n) { AT_WRITE(1); if (i + 2 < n) AT_LOAD(row_of(seq, i + 2)); }
        __syncthreads();
        if (i + 1 < n) {
            tile_body<MODE, 1>(S, L, row_of(seq, i + 1), qb, wid, r32, hi, vb0);
            if (i + 2 < n) { AT_WRITE(0); if (i + 3 < n) AT_LOAD(row_of(seq, i + 3)); }
            __syncthreads();
        }
    }
#undef AT_LOAD
#undef AT_WRITE
}
template <int SM>
__device__ __forceinline__ void store_o(const St& S, LAS char* L, float fac, bf16_t* obase  , int wid, int r32, int hi, unsigned char* obase8 = nullptr) {
    constexpr bool ACCUM = SM != 0;
    LAS float* fl = (LAS float*)(L + L_WS) + wid * 64 + 32;
    if (hi == 0) fl[r32] = fac;
    asm volatile("s_waitcnt lgkmcnt(0)" ::: "memory");
    const bool ev = (r32 & 1) == 0;
    LAS bf16_t* stg = (LAS bf16_t*)(L + L_OST) + wid * (16 * 136);
    const int lane = hi * 32 + r32, rq = lane >> 4, ch = (lane & 15) * 8;
#pragma unroll
    for (int h2 = 0; h2 < 2; ++h2) {
#pragma unroll
        for (int gg = 0; gg < 2; ++gg) { const int g4 = 2 * h2 + gg; const f32x4 f = *(const LAS f32x4*)(fl + 8 * g4 + 4 * hi);
#pragma unroll
            for (int jj = 0; jj < 4; ++jj)
#pragma unroll
                for (int d0 = 0; d0 < 4; ++d0) { const float v = S.o[d0][4 * g4 + jj] * f[jj]; const float vn = __shfl_xor(v, 1);
                    if (ev) *(LAS unsigned*)(stg + (gg * 8 + 4 * hi + jj) * 136 + d0 * 32 + r32) = cvtpk(v, vn); } }
        asm volatile("s_waitcnt lgkmcnt(0)" ::: "memory");
        u32x4 nv[4], ov[4];
#pragma unroll
        for (int it = 0; it < 4; ++it) { const int rowl = it * 4 + rq, row = h2 * 16 + rowl;
            nv[it] = *(const LAS u32x4*)(stg + rowl * 136 + ch);
            if (ACCUM) ov[it] = *(const u32x4*)(obase + (size_t)(row >> 2) * 3072 + (row & 3) * 128 + ch); }
#pragma unroll
        for (int it = 0; it < 4; ++it) { const int row = h2 * 16 + it * 4 + rq; const u32x4 n = nv[it];
            f32x4 a = (f32x4){bflo(n.x), bfhi(n.x), bflo(n.y), bfhi(n.y)}, c = (f32x4){bflo(n.z), bfhi(n.z), bflo(n.w), bfhi(n.w)};
            if (ACCUM) { const u32x4 o = ov[it]; a += (f32x4){bflo(o.x), bfhi(o.x), bflo(o.y), bfhi(o.y)}; c += (f32x4){bflo(o.z), bfhi(o.z), bflo(o.w), bfhi(o.w)}; }
            if (SM == 2) { u32x2 w; w.x = pk4_fp8(a[0] * 16.f, a[1] * 16.f, a[2] * 16.f, a[3] * 16.f); w.y = pk4_fp8(c[0] * 16.f, c[1] * 16.f, c[2] * 16.f, c[3] * 16.f);
                *(u32x2*)(obase8 + (size_t)(row >> 2) * 6144 + (row & 3) * 128 + ch) = w; }
            else if (ACCUM) *(u32x4*)(obase + (size_t)(row >> 2) * 3072 + (row & 3) * 128 + ch) = pack8f(a, c);
            else *(u32x4*)(obase + (size_t)(row >> 2) * 3072 + (row & 3) * 128 + ch) = n; }
        asm volatile("" ::: "memory"); }
}
template <bool FIRST>
__device__ __forceinline__ void acc_o(const St& S, LAS char* L, float fac, unsigned (&tot)[16], int wid, int r32, int hi) {
    LAS float* fl = (LAS float*)(L + L_WS) + wid * 64 + 32;
    LAS unsigned* tl_ = (LAS unsigned*)(L + L_OST + wid * 4352) + (hi * 32 + r32);
    if (hi == 0) fl[r32] = fac;
    asm volatile("s_waitcnt lgkmcnt(0)" ::: "memory");
#pragma unroll
    for (int g4 = 0; g4 < 4; ++g4) { const f32x4 f = *(const LAS f32x4*)(fl + 8 * g4 + 4 * hi);
#pragma unroll
        for (int d0 = 0; d0 < 4; ++d0)
#pragma unroll
            for (int jp = 0; jp < 2; ++jp) { float a = S.o[d0][4 * g4 + 2 * jp] * f[2 * jp], c = S.o[d0][4 * g4 + 2 * jp + 1] * f[2 * jp + 1]; const int k = d0 * 4 + (g4 & 1) * 2 + jp;
                if (g4 < 2) { if (!FIRST) { a += bflo(tot[k]); c += bfhi(tot[k]); } tot[k] = cvtpk(a, c); }
                else { if (!FIRST) { const unsigned t = tl_[k * 64]; a += bflo(t); c += bfhi(t); } tl_[k * 64] = cvtpk(a, c); } } }
    asm volatile("" ::: "memory");
}
__device__ __forceinline__ void store_tot(const unsigned (&tot)[16], LAS char* L, unsigned char* obase8, int wid, int r32, int hi) {
    const bool ev = (r32 & 1) == 0;
    LAS bf16_t* stg = (LAS bf16_t*)(L + L_OST) + wid * (16 * 136);
    const LAS unsigned* tl_ = (const LAS unsigned*)(L + L_OST + wid * 4352) + (hi * 32 + r32);
    unsigned thi[16];
#pragma unroll
    for (int k = 0; k < 16; ++k) thi[k] = tl_[k * 64];
    asm volatile("s_waitcnt lgkmcnt(0)" ::: "memory");
    const int lane = otid() & 63, rq = lane >> 4, ch = (lane & 15) * 8;
#pragma unroll
    for (int h2 = 0; h2 < 2; ++h2) {
#pragma unroll
        for (int gg = 0; gg < 2; ++gg)
#pragma unroll
            for (int jj = 0; jj < 4; ++jj)
#pragma unroll
                for (int d0 = 0; d0 < 4; ++d0) { const int k = d0 * 4 + gg * 2 + (jj >> 1); const unsigned t = h2 ? thi[k] : tot[k]; const float v = (jj & 1) ? bfhi(t) : bflo(t); const float vn = __shfl_xor(v, 1);
                    if (ev) *(LAS unsigned*)(stg + (gg * 8 + 4 * hi + jj) * 136 + d0 * 32 + r32) = cvtpk(v, vn); }
        asm volatile("s_waitcnt lgkmcnt(0)" ::: "memory");
#pragma unroll
        for (int it = 0; it < 4; ++it) { const int rowl = it * 4 + rq, row = h2 * 16 + rowl; const u32x4 n = *(const LAS u32x4*)(stg + rowl * 136 + ch);
            u32x2 w; w.x = pk4_fp8(bflo(n.x) * 16.f, bfhi(n.x) * 16.f, bflo(n.y) * 16.f, bfhi(n.y) * 16.f); w.y = pk4_fp8(bflo(n.z) * 16.f, bfhi(n.z) * 16.f, bflo(n.w) * 16.f, bfhi(n.w) * 16.f);
            *(u32x2*)(obase8 + (size_t)(row >> 2) * 6144 + (row & 3) * 128 + ch) = w; }
        asm volatile("s_waitcnt lgkmcnt(0)" ::: "memory"); }
}
__device__ __forceinline__ void attn_unit(const Ctx& C, int b, int g, int qb) {

    const int tid = otid(), wid = __builtin_amdgcn_readfirstlane(tid >> 6), lane = tid & 63, r32 = lane & 31, hi = lane >> 5, tl = r32 >> 2, hl = r32 & 3;
    LAS char* L = (LAS char*)(C.lds + LDS_STAGE);
    const int t0 = qb * 64, tokl = wid * 8 + tl, bg = b * 2 + g;
    St S; S.tq = t0 + tokl;
    const size_t trow = (size_t)b * SEQ + S.tq; const int head = g * 4 + hl;
    { const int h = tid >> 7, i = tid & 127; ((LAS float*)(L + L_TBL))[tid] = C.in(I_REL)[t5_bucket(i) * 8 + g * 4 + h] * LOG2E; }
    for (int i = tid; i < 4096; i += NTHREADS) ((LAS float*)(L + L_IMP))[i] = 0.f;
    { const bf16_t* qp = C.Z() + trow * LDZ + ZQ + head * 128 + hi * 8;
#pragma unroll
      for (int d0 = 0; d0 < 8; ++d0) S.qr[d0] = *(const bf16x8*)(qp + d0 * 16); }
    const bf16_t* gp = C.Z() + trow * LDZ + ZG24 + head * 3;
    const float g_cmp = bf2f(gp[0]), g_sel = bf2f(gp[1]), g_win = bf2f(gp[2]);
    S.bfar = C.in(I_REL)[31 * 8 + head] * LOG2E;
    unsigned tot[16];
    __syncthreads();
    const int ntc = (4 * qb + 2) / 64 + 1;
    { RowSeq q{0, 64, nullptr}; const bf16_t* Kc = C.KCMP() + (size_t)bg * 256 * 128; const bf16_t* Vc = C.VCMP() + (size_t)bg * 256 * 128;
      S.m = -1e30f; S.l = 0.f;
      attn_loop<M_CMP1>(S, L, ntc, q, Kc, Vc, 128, qb);
      S.rl = S.l > 0.f ? 1.0f / S.l : 0.f;
#pragma unroll
      for (int d = 0; d < 4; ++d) S.o[d] = f32x16{};
      attn_loop<M_CMP2>(S, L, ntc, q, Kc, Vc, 128, qb);
      acc_o<true>(S, L, g_cmp, tot, wid, r32, hi); }
    __syncthreads();
    { const int tk = tid >> 3, sub = tid & 7; const LAS unsigned* ip = (const LAS unsigned*)(L + L_IMP) + tk * 64; unsigned byte = 0;
      if (qb < 16) { const int nv = qb + 1 - sub * 8; byte = nv >= 8 ? 0xffu : (nv > 0 ? (1u << nv) - 1u : 0u); }
      else { unsigned sc[64];
#pragma unroll
        for (int q4 = 0; q4 < 16; ++q4) { const u32x4 v = *(const LAS u32x4*)(ip + q4 * 4); sc[q4 * 4] = v.x; sc[q4 * 4 + 1] = v.y; sc[q4 * 4 + 2] = v.z; sc[q4 * 4 + 3] = v.w; }
#pragma unroll
        for (int n = 0; n < 64; ++n) { const unsigned key = ((sc[n] & ~63u) | (unsigned)(63 - n)) + 64u; sc[n] = (n == 0 || n == qb || n == qb - 1) ? (0xffffff00u | (unsigned)(63 - n)) : (n <= qb ? key : 0u); }
        for (int i = 0; i < 8; ++i) { const int n = sub * 8 + i; unsigned v = ip[n]; v = ((v & ~63u) | (unsigned)(63 - n)) + 64u; v = (n == 0 || n == qb || n == qb - 1) ? (0xffffff00u | (unsigned)(63 - n)) : v; int rank = 0;
#pragma unroll
            for (int k = 0; k < 64; ++k) rank += sc[k] > v ? 1 : 0;
            if (rank < 16 && n <= qb) byte |= 1u << i; } }
      ((LAS unsigned char*)(L + L_SELB))[tk * 8 + sub] = (unsigned char)byte; }
    __syncthreads();
    { const LAS unsigned* mp = (const LAS unsigned*)(L + L_SELB) + tokl * 2; S.mlo = mp[0]; S.mhi = mp[1];
      unsigned ulo = S.mlo, uhi = S.mhi;
#pragma unroll
      for (int o = 32; o >= 1; o >>= 1) { ulo |= __shfl_xor(ulo, o); uhi |= __shfl_xor(uhi, o); }
      if (lane == 0) { ((LAS unsigned*)(L + L_WUN))[wid * 2] = ulo; ((LAS unsigned*)(L + L_WUN))[wid * 2 + 1] = uhi; } }
    __syncthreads();
    if (tid == 0) { unsigned ulo = 0, uhi = 0; for (int w = 0; w < 8; ++w) { ulo |= ((LAS unsigned*)(L + L_WUN))[w * 2]; uhi |= ((LAS unsigned*)(L + L_WUN))[w * 2 + 1]; }
        LAS int* tlst = (LAS int*)(L + L_TL); int n = 0;
        for (int j = 0; j < 64; ++j) { const unsigned bit = j < 32 ? (ulo >> j) & 1u : (uhi >> (j - 32)) & 1u; if (bit) tlst[1 + n++] = b * SEQ + 64 * j; }
        tlst[0] = n; }
    __syncthreads();
    { LAS int* tlst = (LAS int*)(L + L_TL); const int nsel = __builtin_amdgcn_readfirstlane(tlst[0]); RowSeq q{0, 0, tlst + 1};
      const bf16_t* Ks = C.Z() + ZKV + 512 + g * 128; const bf16_t* Vs = C.Z() + ZKV + 768 + g * 128;
      S.m = -1e30f; S.l = 0.f;
#pragma unroll
      for (int d = 0; d < 4; ++d) S.o[d] = f32x16{};
      attn_loop<M_SEL>(S, L, nsel, q, Ks, Vs, LDZ, qb);
      acc_o<false>(S, L, S.l > 0.f ? g_sel / S.l : 0.f, tot, wid, r32, hi); }
    { const int jlo = qb > 8 ? qb - 8 : 0; RowSeq q{b * SEQ + 64 * jlo, 64, nullptr};
      const bf16_t* Kw = C.Z() + ZKV + 1024 + g * 128; const bf16_t* Vw = C.Z() + ZKV + 1280 + g * 128;
      S.m = -1e30f; S.l = 0.f;
#pragma unroll
      for (int d = 0; d < 4; ++d) S.o[d] = f32x16{};
      attn_loop<M_WIN>(S, L, qb - jlo + 1, q, Kw, Vw, LDZ, qb);
      acc_o<false>(S, L, S.l > 0.f ? g_win / S.l : 0.f, tot, wid, r32, hi);
      store_tot(tot, L, (unsigned char*)C.OB() + ((size_t)b * SEQ + t0 + wid * 8) * 6144 + 3072 + (size_t)g * 512, wid, r32, hi); }
    __syncthreads();
}
__device__ __forceinline__ void phase_attn(const Ctx& C) {
    for (int it = C.c; it < 256; it += C.G) { const int bg = it & 7, x = it >> 3;
#pragma unroll 1
        for (int hf = 0; hf < 2; ++hf) attn_unit(C, bg >> 1, bg & 1, hf ? 63 - x : x); }
}
}

constexpr int NPH_LAYER = 16, NPH = 2 * NPH_LAYER + 1;
__global__ void __launch_bounds__(NTHREADS, 2) fwd(Params P) {
    extern __shared__ __attribute__((aligned(16))) unsigned char lds_raw[];
    LAS unsigned char* lds = (LAS unsigned char*)lds_raw;
    Ctx C; C.p = launder_kp(); C.G = gridDim.x; C.c = blockIdx.x; C.lds = lds; C.layer = 0;
    C.ws = P.ws;
    C.x = (float*)launder((unsigned char*)P.out);
    volatile LAS unsigned* bst = (volatile LAS unsigned*)(lds + LDS_MISC + 1024);
    if (threadIdx.x < 4) bst[threadIdx.x] = 0u;
    __syncthreads();
    XcdBarrier bar; bar.bar = (unsigned*)(P.ws + WS_CTL) + CW_BAR; bar.x = 0; bar.st = bst;
    if (P.use_bar) bar = xcd_barrier_post((unsigned*)(P.ws + WS_CTL) + CW_BAR, bst);
    const int lo = P.ph_lo, hi = P.ph_hi;
#ifndef PHMASK
#define PHMASK 0x1ffff
#endif
#define RUN(k) (((PHMASK >> (k)) & 1) && runp(lo, hi, base + (k)))
#define SEAM(k) do { if (runp(lo, hi - 1, base + (k))) xcd_barrier(bar); } while (0)
#ifndef PROBE_NOEPI
#define PROBE_NOEPI 0
#endif
#ifndef PROBE_REP
#define PROBE_REP 0
#endif
#define REP(k) for (int rep_ = 0; rep_ < ((((PROBE_REP) >> (k)) & 1) && layer == 0 ? 2 : 1); ++rep_)
    for (int layer = 0; layer < NLAYER; ++layer) {
        const int base = layer * NPH_LAYER; C.layer = layer;

        REP(0) { if (RUN(0)) { PHASE_ENTER(); phase_prologue(C); }
        SEAM(0); }
        REP(1) { if (RUN(1)) { PHASE_ENTER();
            if (C.c == 0) { for (int i = threadIdx.x; i < 1024; i += NTHREADS) { const int kv = i >> 9, n = i & 511; float s = 0.f; for (int kc = 0; kc < 64; ++kc) s += C.b1p()[(kv * 64 + kc) * 512 + n]; C.b1()[i] = s; } }
            if (layer == 0) phase_rmsnorm<3, false>(C, C.in(I_X), C.in(I_ANORM) + layer * D, C.H(), C.H8()); else phase_rmsnorm<3, true>(C, C.XR(), C.in(I_ANORM) + layer * D, C.H(), C.H8());
        }
        SEAM(1); }
        REP(2) { if (RUN(2)) { PHASE_ENTER();
            { ProbInT<false> q; q.A = C.H(); q.Bt = C.Win() + (size_t)ZCONF * 2048; q.lda = 2048; q.ldb_ = 2048; q.nM = 64; q.nN = 17; q.ntk = 32; q.G = C.G; q.c = C.c; q.O = C.Z() + ZCONF; q.ldo = LDZ; q.O2 = q.O; q.ldo2 = LDZ; q.n1 = 64; pg8::gemm_phase(C.lds + LDS_STAGE, q); }
            { ProbInT<true> q; q.A = (const bf16_t*)C.H8(); q.Bt = (const bf16_t*)C.Wmg(); q.lda = 1024; q.ldb_ = 1024; q.nM = 64; q.nN = 38; q.ntk = 16; q.G = C.G; q.c = C.c; q.O = C.GB(); q.ldo = LDG; q.O2 = C.Z(); q.ldo2 = LDZ; q.n1 = LDG / 256; pg8::gemm_phase(C.lds + LDS_STAGE, q); } }
        SEAM(2); }
        REP(3) { if (RUN(3)) { PHASE_ENTER();
            phase_conv(C);
            ProbC1 q; q.Z = C.Z(); q.Wc1 = C.Wc1(); q.slab = (float*)C.MRG(); q.c = C.c; pg8::gemm_phase(C.lds + LDS_STAGE, q);
        }
        SEAM(3); }
        REP(4) { if (RUN(4)) { PHASE_ENTER(); phase_c1_reduce(C, (const float*)C.MRG()); if (C.p->use_bar) xcd_barrier(bar); PHASE_ENTER(); ProbC2 q; q.A = C.HID(); q.Bt = C.Wc2(); q.lda = 512; q.ldb_ = 512; q.nM = 16; q.nN = 1; q.ntk = 8; q.G = C.G; q.c = C.c; q.KC = C.KCMP(); q.VC = C.VCMP(); pg8::gemm_phase(C.lds + LDS_STAGE, q); }
        SEAM(4); }
        REP(5) { if (RUN(5)) { PHASE_ENTER(); at::phase_attn(C); }
        SEAM(5); }
        REP(6) { if (RUN(6)) { PHASE_ENTER();
            { ProbBr<false> q; q.OB = C.OB(); q.Wbr = C.Wbr(); q.Z = C.GB(); q.MRG = C.MRG(); q.G = C.G; q.c = C.c; pg8::gemm_phase(C.lds + LDS_STAGE, q); }
            { ProbBr<true> q; q.OB = C.OB(); q.Wbr = C.Wbr(); q.Z = C.GB(); q.MRG = C.MRG(); q.G = C.G; q.c = C.c; pg8::gemm_phase(C.lds + LDS_STAGE, q); } }
        SEAM(6); }
        REP(7) { if (RUN(7)) { PHASE_ENTER();
            if (layer == 0) { ProbOut<false> q; q.A = C.MRG(); q.Bt = C.Wout(); q.lda = 2048; q.ldb_ = 2048; q.nM = 64; q.nN = 8; q.ntk = 32; q.G = C.G; q.c = C.c; q.xin = C.in(I_X); q.xout = C.XR(); pg8::gemm_phase(C.lds + LDS_STAGE, q); }
            else { ProbOut<true> q; q.A = C.MRG(); q.Bt = C.Wout(); q.lda = 2048; q.ldb_ = 2048; q.nM = 64; q.nN = 8; q.ntk = 32; q.G = C.G; q.c = C.c; q.xin = C.XR(); q.xout = C.XR(); pg8::gemm_phase(C.lds + LDS_STAGE, q); } }
        SEAM(7); }
        REP(8) { if (RUN(8)) { PHASE_ENTER(); phase_rmsnorm<2, true>(C, C.XR(), C.in(I_FNORM) + layer * D, C.H(), C.H8(), C.RS()); }
        SEAM(8); }
        REP(9) { if (RUN(9)) { PHASE_ENTER(); ProbRt q; q.A = C.XR(); q.Bt = C.Wr(); q.lda = 2048; q.ldb_ = 2048; q.nM = 64; q.nN = 1; q.ntk = 8; q.G = C.G; q.c = C.c; q.LOG = C.LOG(); pg8::gemm_phase(C.lds + LDS_STAGE, q); }
        SEAM(9); }
        REP(10) { if (RUN(10)) { PHASE_ENTER(); phase_route(C); }
        SEAM(10); }
        REP(11) { if (RUN(11)) { PHASE_ENTER(); phase_slots(C); }
        SEAM(11); }
        REP(12) { if (RUN(12)) { PHASE_ENTER(); ProbUp q; q.H8 = C.H8(); q.Wgu = (const unsigned char*)C.Wgu(); q.HE = (unsigned char*)C.HE(); q.stok = C.stok(); q.texp = C.texp(); q.ntile = __builtin_amdgcn_readfirstlane((int)C.ctl()[CW_NTILE + layer]); q.G = C.G; q.c = C.c; pg8::gemm_phase(C.lds + LDS_STAGE, q); }
        SEAM(12); }
        REP(13) { if (RUN(13)) { PHASE_ENTER(); ProbDn q; q.HE = (const unsigned char*)C.HE(); q.Wd = (const unsigned char*)C.Wd(); q.YB = C.YB(); q.sdst = C.sdst(); q.sw = C.sw(); q.texp = C.texp(); q.ntile = __builtin_amdgcn_readfirstlane((int)C.ctl()[CW_NTILE + layer]); q.G = C.G; q.c = C.c; pg8::gemm_phase(C.lds + LDS_STAGE, q); }
        SEAM(13); }
        REP(14) { if (RUN(14)) { PHASE_ENTER(); phase_combine_norm(C, C.in(I_PNORM) + layer * D); }
        SEAM(14); }
        REP(15) { if (RUN(15)) { PHASE_ENTER();
            { ProbPp q; q.A = C.PB(); q.Bt = C.Wpp(); q.lda = 256; q.ldb_ = 256; q.nM = 64; q.nN = 8; q.ntk = 4; q.G = C.G; q.c = C.c; q.PP = C.PP(); pg8::gemm_phase(C.lds + LDS_STAGE, q); }
            __syncthreads();
            { ProbPg q; q.A = (const bf16_t*)C.H8(); q.Bt = C.Wpg(); q.lda = 1024; q.ldb_ = 1024; q.nM = 64; q.nN = 8; q.ntk = 16; q.G = C.G; q.c = C.c; q.PP = C.PP(); q.x = C.XR(); pg8::gemm_phase(C.lds + LDS_STAGE, q); }
        }
        SEAM(15); }
    }
    { const int base = 2 * NPH_LAYER; if (RUN(0)) { PHASE_ENTER(); phase_final_norm(C, C.in(I_FINAL)); } }
#undef RUN
#undef SEAM
}

#ifndef N_LAUNCH_MODE
#define N_LAUNCH_MODE 1
#endif
extern "C" void kernel_launch(void* const* d_in, const int* in_sizes, int n_in, void* d_out, int out_size, void* d_ws, size_t ws_size, hipStream_t stream) {
    static int grid = 0;
    if (grid == 0) {
        if (n_in != 27 || in_sizes[0] != T * D || out_size != T * D || ws_size < WS_END) {
            fprintf(stderr, "kernel_launch: unexpected problem (n_in %d, in0 %d, out %d, ws %zu, need %zu)\n", n_in, n_in > 0 ? in_sizes[0] : -1, out_size, ws_size, (size_t)WS_END); grid = -1; return; }
        int dev = 0, cus = 0, per_cu = 0;
        if (hipGetDevice(&dev) != hipSuccess || hipDeviceGetAttribute(&cus, hipDeviceAttributeMultiprocessorCount, dev) != hipSuccess) { grid = -1; return; }
        if (hipFuncSetAttribute((const void*)fwd, hipFuncAttributeMaxDynamicSharedMemorySize, LDS_BYTES) != hipSuccess) { fprintf(stderr, "kernel_launch: hipFuncSetAttribute failed\n"); grid = -1; return; }
        if (hipOccupancyMaxActiveBlocksPerMultiprocessor(&per_cu, (const void*)fwd, NTHREADS, LDS_BYTES) != hipSuccess || per_cu < 1) fprintf(stderr, "kernel_launch: occupancy query reports %d\n", per_cu);
        (void)hipGetLastError();
        grid = cus;
    }
    if (grid < 0) return;
    (void)hipMemsetAsync((char*)d_ws + WS_CTL, 0, CTL_BYTES, stream);
    Params p{};
    for (int i = 0; i < 27; ++i) p.in[i] = (const float*)d_in[i];
    p.out = (float*)d_out; p.ws = (unsigned char*)d_ws;
#if N_LAUNCH_MODE == 1
    p.ph_lo = 0; p.ph_hi = NPH; p.use_bar = 1;
    hipLaunchKernelGGL(fwd, dim3(grid), dim3(NTHREADS), LDS_BYTES, stream, p);
#else
    for (int ph = 0; ph < NPH; ++ph) { p.ph_lo = ph; p.ph_hi = ph + 1; p.use_bar = 0; hipLaunchKernelGGL(fwd, dim3(grid), dim3(NTHREADS), LDS_BYTES, stream, p); }
#endif
}
```

```cpp
#include <hip/hip_runtime.h>
#include <cstdio>
#include <cstdint>

#define LAS __attribute__((address_space(3)))
typedef unsigned short bf16_t;
typedef short bf16x8 __attribute__((ext_vector_type(8)));
typedef short s16x4 __attribute__((ext_vector_type(4)));
typedef float f32x4 __attribute__((ext_vector_type(4)));
typedef float f32x2 __attribute__((ext_vector_type(2)));
typedef float f32x16 __attribute__((ext_vector_type(16)));
typedef unsigned u32x4 __attribute__((ext_vector_type(4)));
typedef unsigned u32x2 __attribute__((ext_vector_type(2)));
typedef unsigned long long u64;
typedef __bf16 bfp2 __attribute__((ext_vector_type(2)));

constexpr int T = 16384, D = 2048, SEQ = 4096, NBATCH = 4, NLAYER = 2;
constexpr int LDZ = 6912;
constexpr int ZQ = 0, ZKV = 1024, ZCONF = 2560, ZSC = 3584, ZG24 = 6656;
constexpr int LDG = 7168, GCONF = 6144;
constexpr int IN_W = 13848;
constexpr int NSLOT = 40960;
constexpr int NTHREADS = 512;
constexpr float LOG2E = 1.4426950408889634f;
constexpr float RMS_EPS = 1e-6f;

constexpr size_t al256(size_t x) { return (x + 255) & ~(size_t)255; }
constexpr size_t WS_CTL = 0;
constexpr size_t CTL_BYTES = 65536;
constexpr size_t WS_WIN = WS_CTL + CTL_BYTES;
constexpr size_t WS_WMG = WS_WIN + (size_t)LDZ * 2048 * 2;
constexpr size_t WS_WC1 = WS_WIN + (size_t)14080 * 2048 * 2;
constexpr size_t WS_WC2 = WS_WC1 + (size_t)2 * 512 * 4096 * 2;
constexpr size_t WS_WBR = WS_WC2 + (size_t)256 * 512 * 2;
constexpr size_t WS_WOUT = WS_WBR + (size_t)2048 * 3072 * 2;
constexpr size_t WS_WR = WS_WOUT + (size_t)2048 * 2048 * 2;
constexpr size_t WS_WGU = WS_WR + (size_t)256 * 2048 * 2;
constexpr size_t WS_WD = WS_WGU + (size_t)32 * 1024 * 2048 * 2;
constexpr size_t WS_WPG = WS_WD + (size_t)32 * 2048 * 512 * 2;
constexpr size_t WS_WPP = WS_WPG + (size_t)2048 * 2048 * 2;
constexpr size_t WS_B1P = WS_WPP + (size_t)2048 * 256 * 2;
constexpr size_t WS_B1 = WS_B1P + (size_t)2 * 64 * 512 * 4;
constexpr size_t WS_H = al256(WS_B1 + 2 * 512 * 4);
constexpr size_t WS_Z = WS_H + (size_t)T * 2048 * 2;
constexpr size_t Z_BYTES = (size_t)(T + 32) * LDZ * 2;
constexpr size_t WS_OB = WS_Z + Z_BYTES;
constexpr size_t WS_MRG = WS_OB + (size_t)T * 3072 * 2;
constexpr size_t WS_HID = WS_MRG + (size_t)T * 2048 * 2;
constexpr size_t WS_KCMP = WS_HID + (size_t)4096 * 512 * 2;
constexpr size_t WS_VCMP = WS_KCMP + (size_t)8 * 256 * 128 * 2;
constexpr size_t WS_PB = WS_VCMP + (size_t)8 * 256 * 128 * 2;
constexpr size_t WS_LOG = WS_PB + (size_t)T * 256 * 2;
constexpr size_t WS_TOKE = WS_LOG + (size_t)4 * T * 64 * 4;
constexpr size_t WS_TOKP = WS_TOKE + (size_t)T * 2 * 4;
constexpr size_t WS_TOKW = WS_TOKP + (size_t)T * 2 * 4;
constexpr size_t WS_STOK = WS_TOKW + (size_t)T * 2 * 4;
constexpr size_t WS_SDST = WS_STOK + (size_t)NSLOT * 4;
constexpr size_t WS_SW = WS_SDST + (size_t)NSLOT * 4;
constexpr size_t WS_TEXP = WS_SW + (size_t)NSLOT * 4;
constexpr size_t WS_GB = al256(WS_TEXP + 1024);
constexpr size_t WS_H8 = WS_GB + (size_t)T * LDG * 2;
constexpr size_t WS_XR = WS_H8 + (size_t)T * 2048;
constexpr size_t WS_RS = WS_XR + (size_t)T * 2048 * 2;
constexpr size_t WS_END = WS_RS + (size_t)T * 4;
constexpr size_t WS_HE = WS_Z;
constexpr size_t WS_YB = WS_HE + (size_t)NSLOT * 512;
constexpr size_t WS_PP = WS_YB + (size_t)(2 * T + 8) * 2048 * 2;
static_assert(WS_PP + (size_t)T * 2048 * 2 <= WS_Z + Z_BYTES, "aliases must fit in z");
constexpr int CW_BAR = 0;
constexpr int CW_CNT = 4096;
constexpr int CW_NTILE = 4096 + 128;

constexpr int LDS_STAGE = 0;
constexpr int LDS_MISC = 131072;
constexpr int LDS_BYTES = 131072 + 20480;

#define XB_TMO      128
#define XB_XCNT(j)  (256  + 64 * (j))
#define XB_XSUB(j)  (1280 + 64 * (j))
#define XB_XGEN(j)  (2304 + 64 * (j))
#define XB_TOP      3328
#define XB_TOPGEN   3392
#define XCD_BAR_WORDS 3456
#define XB_SPIN_CAP (1u << 20)
__device__ __forceinline__ unsigned xb_ld(unsigned* p)              { return __hip_atomic_load(p, __ATOMIC_RELAXED, __HIP_MEMORY_SCOPE_AGENT); }
__device__ __forceinline__ unsigned xb_add(unsigned* p, unsigned v) { return __hip_atomic_fetch_add(p, v, __ATOMIC_RELAXED, __HIP_MEMORY_SCOPE_AGENT); }
__device__ __forceinline__ unsigned xb_xcc_id() { return (unsigned)__builtin_amdgcn_s_getreg((3 << 11) | 20) & 0xFu; }
#define XB_SPIN(cond, bar) do { unsigned _sp = 0; while (cond) { __builtin_amdgcn_s_sleep(1); \
    if ((++_sp & 255u) == 0u) { if (xb_ld(&(bar)[XB_TMO])) break; if (_sp > XB_SPIN_CAP) { atomicAdd(&(bar)[XB_TMO], 1u); break; } } } } while (0)
struct XcdBarrier { unsigned* bar; unsigned x; volatile LAS unsigned* st; };
__device__ __forceinline__ XcdBarrier xcd_barrier_post(unsigned* bar, volatile LAS unsigned* st) {
    XcdBarrier b; b.bar = bar; b.x = xb_xcc_id(); b.st = st;
    if (threadIdx.x == 0) (void)xb_add(&bar[XB_XCNT(b.x)], 1u);
    return b;
}
__device__ __forceinline__ void xcd_barrier_complete(unsigned* bar, unsigned x, unsigned& nloc, unsigned& nx) {
    const unsigned G = gridDim.x * gridDim.y * gridDim.z;
    unsigned sum, cnt, mine, sp = 0u;
    for (;;) {
        sum = 0u; cnt = 0u; mine = 0u;
#pragma unroll
        for (unsigned j = 0; j < 16; ++j) { const unsigned c = xb_ld(&bar[XB_XCNT(j)]); sum += c; cnt += (c > 0u) ? 1u : 0u; mine = (j == x) ? c : mine; }
        if (sum == G) break;
        __builtin_amdgcn_s_sleep(1);
        if ((++sp & 255u) == 0u) { if (xb_ld(&bar[XB_TMO])) break; if (sp > XB_SPIN_CAP) { atomicAdd(&bar[XB_TMO], 1u); break; } }
    }
    nloc = mine > 0u ? mine : 1u; nx = cnt > 0u ? cnt : 1u;
}
__device__ __forceinline__ void xcd_barrier(const XcdBarrier& b) {
    asm volatile("s_waitcnt vmcnt(0)" ::: "memory");
    __syncthreads();
    if (threadIdx.x == 0) {
        unsigned bx = b.x; __attribute__((address_space(1))) unsigned* barg = (__attribute__((address_space(1))) unsigned*)b.bar;
        asm volatile("" : "+s"(barg), "+s"(bx)); unsigned* bar = (unsigned*)barg;
        __builtin_amdgcn_s_waitcnt(0);
        unsigned nloc = b.st[0], nx = b.st[1];
        if (nloc == 0u) { xcd_barrier_complete(bar, bx, nloc, nx); b.st[0] = nloc; b.st[1] = nx; }
        const unsigned old = xb_add(&bar[XB_XSUB(bx)], 1u);
        const unsigned gen = old / nloc;
        if (old + 1u == (gen + 1u) * nloc) {
            __builtin_amdgcn_fence(__ATOMIC_RELEASE, "agent");
            asm volatile("s_waitcnt vmcnt(0)" ::: "memory");
            const unsigned og = xb_add(&bar[XB_TOP], 1u);
            const unsigned tg = og / nx;
            if (og + 1u == (tg + 1u) * nx) xb_add(&bar[XB_TOPGEN], 1u);
            else XB_SPIN(xb_ld(&bar[XB_TOPGEN]) == tg, bar);
            __builtin_amdgcn_fence(__ATOMIC_ACQUIRE, "agent");
            xb_add(&bar[XB_XGEN(bx)], 1u);
            asm volatile("s_waitcnt vmcnt(0)" ::: "memory");
        } else {
            XB_SPIN(xb_ld(&bar[XB_XGEN(bx)]) == gen, bar);
            __builtin_amdgcn_fence(__ATOMIC_ACQUIRE, "agent");
            asm volatile("s_waitcnt vmcnt(0)" ::: "memory");
        }
    }
    __syncthreads();
}

__device__ __forceinline__ unsigned cvtpk(float lo, float hi) { unsigned r; asm volatile("v_cvt_pk_bf16_f32 %0, %1, %2" : "=v"(r) : "v"(lo), "v"(hi)); return r; }
__device__ __forceinline__ float bf2f(unsigned short b) { return __uint_as_float(((unsigned)b) << 16); }
__device__ __forceinline__ float bflo(unsigned w) { return __uint_as_float(w << 16); }
__device__ __forceinline__ float bfhi(unsigned w) { return __uint_as_float(w & 0xffff0000u); }
__device__ __forceinline__ float sigmoidf_(float x) { return __builtin_amdgcn_rcpf(1.0f + __builtin_amdgcn_exp2f(-x * LOG2E)); }
__device__ __forceinline__ float siluf_(float x) { return x * sigmoidf_(x); }
__device__ __forceinline__ float gelu_tanh(float x) { return x * sigmoidf_(1.5957691216057308f * (x + 0.044715f * x * x * x)); }
__device__ __forceinline__ u32x4 pack8f(const f32x4 a, const f32x4 b) { u32x4 w; w.x = cvtpk(a[0], a[1]); w.y = cvtpk(a[2], a[3]); w.z = cvtpk(b[0], b[1]); w.w = cvtpk(b[2], b[3]); return w; }
__device__ __forceinline__ int opaque_s0(int v) { asm volatile("" : "+s"(v)); return v; }
__device__ __forceinline__ int otid() { int t = threadIdx.x; asm volatile("" : "+v"(t)); return t; }
__device__ __forceinline__ float wave_sum(float v) {
#pragma unroll
    for (int o = 32; o >= 1; o >>= 1) v += __shfl_xor(v, o);
    return v;
}

namespace pg8 {
constexpr int BM = 256, BK = 64, HALF = 128, HTB = HALF * BK * 2, STAGE_BYTES = 8 * HTB, NXCD = 8, WGM = 8;
__host__ __device__ __forceinline__ int lds_byte(int r, int c) { const int st = (r >> 4) * 2 + (c >> 5), rr = r & 15, cc = c & 31, ob = rr * 64 + cc * 2; return st * 1024 + (ob ^ (((ob >> 9) & 1) << 5)); }
__host__ __device__ __forceinline__ void stage_rc(int b, int& R, int& C) { const int st = b / 1024, sb = b % 1024, swz = sb ^ (((sb >> 9) & 1) << 5); R = (st >> 1) * 16 + swz / 64; C = (st & 1) * 32 + (swz % 64) / 2; }
__host__ __device__ __forceinline__ int perm32(int rho) { const int n = rho >> 4, i = rho & 15; return 8 * (i >> 2) + 4 * n + (i & 3); }
struct Unit { int pm, pn, aux; };
typedef int v8i __attribute__((ext_vector_type(8)));
typedef int v4i __attribute__((ext_vector_type(4)));
__device__ __forceinline__ v8i cat8(const bf16x8 a, const bf16x8 b) { typedef int v4i __attribute__((ext_vector_type(4))); const v4i x = __builtin_bit_cast(v4i, a), y = __builtin_bit_cast(v4i, b); return (v8i){x[0], x[1], x[2], x[3], y[0], y[1], y[2], y[3]}; }

__device__ __forceinline__ bool static_unit(int L, int nM, int nN, Unit& u) {
    const int nwg = nM * nN; if (L >= nwg) return false;
    int wgid = L; { const int q = nwg / NXCD, r = nwg % NXCD, xcd = wgid % NXCD, off = wgid / NXCD; wgid = (xcd < r ? xcd * (q + 1) : r * (q + 1) + (xcd - r) * q) + off; }
    const int nig = WGM * nN, gid = wgid / nig, fm = gid * WGM, gsz = (nM - fm) < WGM ? (nM - fm) : WGM;
    u.pm = fm + ((wgid % nig) % gsz); u.pn = (wgid % nig) / gsz; u.aux = 0; return true;
}

template <class P>
__device__ __forceinline__ void gemm_phase(LAS unsigned char* lds, const P& p) {
    const int tid = otid(), wid = __builtin_amdgcn_readfirstlane(tid >> 6), lane = tid & 63, wr = wid >> 2, wc = wid & 3, fr = lane & 15, fq = lane >> 4;
    Unit cur, nxt; int ui = 0;
    if (!p.next(0, cur)) return;
    int Rr[2], Cc[2]; unsigned voffB[2][2], voffA[2][2], nvoffA[2][2];
    const int ldb = p.ldb();
#pragma unroll
    for (int i = 0; i < 2; ++i) { int R, C; stage_rc(tid * 16 + i * 8192, R, C); Rr[i] = R; Cc[i] = C; const int Rb = (R & ~31) + perm32(R & 31);
#pragma unroll
        for (int h = 0; h < 2; ++h) { voffB[h][i] = (unsigned)(Rb * ldb + C) * 2u; voffA[h][i] = p.a_off(cur, h, R, C); nvoffA[h][i] = voffA[h][i]; } }
    const size_t hB = (size_t)HALF * ldb * 2, hA = p.a_hofs();
    const unsigned ldsw = (unsigned)wid * 1024u;
    const int aoff = lds_byte(wr * 64 + fr, fq * 8), boff = lds_byte(wc * 32 + fr, fq * 8);
#define PG8_SA(b, h) (((b) * 2 + (h)) * HTB)
#define PG8_SB(b, h) ((4 + (b) * 2 + (h)) * HTB)
#define PG8_STAGE(bufoff, gbase, voff) do { _Pragma("unroll") for (int _i = 0; _i < 2; ++_i) \
        __builtin_amdgcn_global_load_lds((const unsigned*)((const char*)(gbase) + (voff)[_i]), (LAS unsigned*)(lds + (bufoff) + ldsw + _i * 8192), 16, 0, 0); } while (0)
#define PG8_LD8(p_) __builtin_shufflevector(*(const LAS v4i*)(p_), *(const LAS v4i*)((p_) + 1024), 0, 1, 2, 3, 4, 5, 6, 7)
#define PG8_LDA(dst, b, h) do { if constexpr (P::FP8) { _Pragma("unroll") for (int m = 0; m < 4; ++m) dst##8[m] = PG8_LD8(lds + PG8_SA(b, h) + aoff + m * 2048); } \
        else { _Pragma("unroll") for (int m = 0; m < 4; ++m) _Pragma("unroll") for (int k = 0; k < 2; ++k) dst[m][k] = *(const LAS bf16x8*)(lds + PG8_SA(b, h) + aoff + m * 2048 + k * 1024); } } while (0)
#define PG8_LDB(dst, b, h) do { if constexpr (P::FP8) { _Pragma("unroll") for (int n = 0; n < 2; ++n) dst##8[n] = PG8_LD8(lds + PG8_SB(b, h) + boff + n * 2048); } \
        else { _Pragma("unroll") for (int n = 0; n < 2; ++n) _Pragma("unroll") for (int k = 0; k < 2; ++k) dst[n][k] = *(const LAS bf16x8*)(lds + PG8_SB(b, h) + boff + n * 2048 + k * 1024); } } while (0)
#define PG8_MMA(ai, bj, At, Bt) do { __builtin_amdgcn_s_setprio(1); \
        if constexpr (P::FP8) { _Pragma("unroll") for (int m = 0; m < 4; ++m) _Pragma("unroll") for (int n = 0; n < 2; ++n) \
            asm volatile("v_mfma_scale_f32_16x16x128_f8f6f4 %0, %1, %2, %0, %3, %3 op_sel_hi:[0,0,0]" : "+v"(acc[ai][bj][m][n]) : "v"(Bt##8[n]), "v"(At##8[m]), "v"(sc127)); } \
        else { _Pragma("unroll") for (int m = 0; m < 4; ++m) _Pragma("unroll") for (int n = 0; n < 2; ++n) _Pragma("unroll") for (int k = 0; k < 2; ++k) \
            acc[ai][bj][m][n] = __builtin_amdgcn_mfma_f32_16x16x32_bf16(Bt[n][k], At[m][k], acc[ai][bj][m][n], 0, 0, 0); } \
        __builtin_amdgcn_s_setprio(0); } while (0)
#define PG8_WAIT_V(n) asm volatile("s_waitcnt vmcnt(" #n ")" ::: "memory")
#define PG8_WAIT_L(n) asm volatile("s_waitcnt lgkmcnt(" #n ")" ::: "memory")
#define PG8_BAR __builtin_amdgcn_s_barrier()
#define PG8_SCHED __builtin_amdgcn_sched_barrier(0)
    float zf = 0.f; asm volatile("" : "+v"(zf));
    f32x4 acc[2][2][4][2];
#pragma unroll
    for (int a = 0; a < 2; ++a)
#pragma unroll
        for (int b = 0; b < 2; ++b)
#pragma unroll
            for (int m = 0; m < 4; ++m)
#pragma unroll
                for (int n = 0; n < 2; ++n) acc[a][b][m][n] = (f32x4){zf, zf, zf, zf};
    const int sc127 = 127;
    bf16x8 At[4][2], B0[2][2], B1[2][2]; v8i At8[4], B08[2], B18[2];
    const char* cA = p.a_base(cur); const char* cB = p.b_base(cur);
    const size_t k1a = p.a_kofs(1);
    PG8_STAGE(PG8_SB(0, 0), cB, voffB[0]); PG8_STAGE(PG8_SB(0, 1), cB + hB, voffB[1]); PG8_STAGE(PG8_SA(0, 0), cA, voffA[0]); PG8_STAGE(PG8_SA(0, 1), cA + hA, voffA[1]);
    if (wr == 1) PG8_BAR;
    PG8_WAIT_V(2); PG8_BAR;
    PG8_STAGE(PG8_SB(1, 0), cB + 128, voffB[0]); PG8_STAGE(PG8_SA(1, 0), cA + k1a, voffA[0]); PG8_STAGE(PG8_SB(1, 1), cB + hB + 128, voffB[1]);
    PG8_WAIT_V(6); PG8_BAR;
    for (;;) {
        const bool has_next = p.next(ui + 1, nxt);
        const int nt = p.nt(cur);
        const char* nA = has_next ? p.a_base(nxt) : cA; const char* nB = has_next ? p.b_base(nxt) : cB;
        if constexpr (P::A_PER_UNIT) { if (has_next) {
#pragma unroll
            for (int i = 0; i < 2; ++i)
#pragma unroll
                for (int h = 0; h < 2; ++h) nvoffA[h][i] = p.a_off(nxt, h, Rr[i], Cc[i]);
            asm volatile("" : "+v"(nvoffA[0][0]), "+v"(nvoffA[0][1]), "+v"(nvoffA[1][0]), "+v"(nvoffA[1][1])); } }
        for (int t = 0; t < nt; t += 2) {
            const bool last = (t == nt - 2);
            const char* a1 = cA + p.a_kofs(t + 1);
            const char* a2 = last ? nA : cA + p.a_kofs(t + 2); const char* b2 = last ? nB : cB + (size_t)(t + 2) * 128;
            const char* a3 = last ? nA + k1a : cA + p.a_kofs(t + 3); const char* b3 = b2 + 128;
            unsigned vA0[2], vA1[2];
            if constexpr (P::A_PER_UNIT) { vA0[0] = last ? nvoffA[0][0] : voffA[0][0]; vA0[1] = last ? nvoffA[0][1] : voffA[0][1]; vA1[0] = last ? nvoffA[1][0] : voffA[1][0]; vA1[1] = last ? nvoffA[1][1] : voffA[1][1]; }
            else { vA0[0] = voffA[0][0]; vA0[1] = voffA[0][1]; vA1[0] = voffA[1][0]; vA1[1] = voffA[1][1]; }
            PG8_LDB(B0, 0, 0); PG8_LDB(B1, 0, 1); PG8_SCHED; PG8_LDA(At, 0, 0); PG8_STAGE(PG8_SA(1, 1), a1 + hA, voffA[1]);
            PG8_WAIT_V(8); PG8_WAIT_L(0); PG8_BAR; PG8_MMA(0, 0, At, B0); PG8_MMA(0, 1, At, B1); PG8_BAR; PG8_SCHED;
            PG8_LDA(At, 0, 1); PG8_STAGE(PG8_SB(0, 0), b2, voffB[0]); PG8_STAGE(PG8_SB(0, 1), b2 + hB, voffB[1]); PG8_STAGE(PG8_SA(0, 0), a2, vA0);
            PG8_WAIT_V(8); PG8_WAIT_L(0); PG8_BAR; PG8_MMA(1, 0, At, B0); PG8_MMA(1, 1, At, B1); PG8_BAR; PG8_SCHED;
            PG8_LDB(B0, 1, 0); PG8_LDB(B1, 1, 1); PG8_SCHED; PG8_LDA(At, 1, 0); PG8_STAGE(PG8_SA(0, 1), a2 + hA, vA1);
            PG8_WAIT_V(8); PG8_WAIT_L(0); PG8_BAR; PG8_MMA(0, 0, At, B0); PG8_MMA(0, 1, At, B1); PG8_BAR; PG8_SCHED;
            PG8_LDA(At, 1, 1); PG8_STAGE(PG8_SB(1, 0), b3, voffB[0]); PG8_STAGE(PG8_SB(1, 1), b3 + hB, voffB[1]); PG8_STAGE(PG8_SA(1, 0), a3, vA0);
            PG8_WAIT_V(8); PG8_WAIT_L(0); PG8_BAR; PG8_MMA(1, 0, At, B0); PG8_MMA(1, 1, At, B1); PG8_BAR; PG8_SCHED;
        }
        if (wr == 0) PG8_BAR;
        p.epi(acc, cur, wr, wc, fr, fq);
        if (!has_next) break;
        zf = 0.f; asm volatile("" : "+v"(zf));
#pragma unroll
        for (int a = 0; a < 2; ++a)
#pragma unroll
            for (int b = 0; b < 2; ++b)
#pragma unroll
                for (int m = 0; m < 4; ++m)
#pragma unroll
                    for (int n = 0; n < 2; ++n) acc[a][b][m][n] = (f32x4){zf, zf, zf, zf};
        cur = nxt; cA = nA; cB = nB; ++ui;
        if constexpr (P::A_PER_UNIT) {
#pragma unroll
            for (int i = 0; i < 2; ++i)
#pragma unroll
                for (int h = 0; h < 2; ++h) voffA[h][i] = nvoffA[h][i]; }
        if (wr == 1) PG8_BAR;
    }
    PG8_WAIT_V(0);
    PG8_BAR;
#undef PG8_SA
#undef PG8_SB
#undef PG8_STAGE
#undef PG8_LDA
#undef PG8_LDB
#undef PG8_MMA
#undef PG8_WAIT_V
#undef PG8_WAIT_L
#undef PG8_BAR
#undef PG8_SCHED
}
}
typedef f32x4 Acc[2][2][4][2];

struct Params {
    const float* in[27];
    float* out;
    unsigned char* ws;
    int ph_lo, ph_hi;
    int use_bar, pad;
};
enum { I_X = 0, I_P, I_REL, I_ANORM, I_WIN, I_PE, I_W1, I_W2, I_CCW, I_CCB, I_CLG, I_CLB, I_SCW, I_WBR, I_WOUT, I_FNORM, I_RGW, I_RGB, I_REW, I_REB, I_WG, I_WU, I_WD, I_PNORM, I_PGW, I_PPW, I_FINAL };

typedef const __attribute__((address_space(4))) Params* KP;
struct Ctx {
    KP p; int layer; int G, c;
    LAS unsigned char* lds;
    unsigned char* ws;
#define GAS __attribute__((address_space(1)))
#define WSP(name, type, off) __device__ __forceinline__ type* name() const { return (type*)(ws + (off)); }
    __device__ __forceinline__ const float* in(int i) const { GAS const float* g = (GAS const float*)p->in[i]; asm volatile("" : "+s"(g)); return (const float*)g; }
    WSP(ctl, unsigned, WS_CTL)
    WSP(Win, bf16_t, WS_WIN) WSP(Wc1, bf16_t, WS_WC1) WSP(Wc2, bf16_t, WS_WC2) WSP(Wbr, bf16_t, WS_WBR) WSP(Wout, bf16_t, WS_WOUT)
    WSP(Wr, bf16_t, WS_WR) WSP(Wgu, bf16_t, WS_WGU) WSP(Wd, bf16_t, WS_WD) WSP(Wpg, bf16_t, WS_WPG) WSP(Wpp, bf16_t, WS_WPP)
    WSP(b1p, float, WS_B1P) WSP(b1, float, WS_B1)
    WSP(H, bf16_t, WS_H) WSP(H8, unsigned char, WS_H8) WSP(XR, bf16_t, WS_XR) WSP(RS, float, WS_RS) WSP(GB, bf16_t, WS_GB) WSP(Wmg, unsigned char, WS_WMG) WSP(Z, bf16_t, WS_Z) WSP(OB, bf16_t, WS_OB) WSP(MRG, bf16_t, WS_MRG) WSP(HID, bf16_t, WS_HID)
    WSP(KCMP, bf16_t, WS_KCMP) WSP(VCMP, bf16_t, WS_VCMP) WSP(PB, bf16_t, WS_PB) WSP(HE, bf16_t, WS_HE) WSP(YB, bf16_t, WS_YB) WSP(PP, bf16_t, WS_PP)
    WSP(LOG, float, WS_LOG) WSP(toke, int, WS_TOKE) WSP(tokp, int, WS_TOKP) WSP(tokw, float, WS_TOKW)
    WSP(stok, int, WS_STOK) WSP(sdst, int, WS_SDST) WSP(sw, float, WS_SW) WSP(texp, int, WS_TEXP)
#undef WSP
    float* x;
};
__device__ __forceinline__ unsigned char* launder(unsigned char* p) { GAS unsigned char* g = (GAS unsigned char*)p; asm volatile("" : "+s"(g)); return (unsigned char*)g; }
__device__ __forceinline__ bool runp(int lo, int hi, int ph) { asm volatile("" : "+s"(lo), "+s"(hi)); return lo <= ph && ph < hi; }
__device__ __forceinline__ KP launder_kp() { KP k = (KP)__builtin_amdgcn_kernarg_segment_ptr(); asm volatile("" : "+s"(k)); return k; }
__device__ __forceinline__ int opaque_s(int v) { asm volatile("" : "+s"(v)); return v; }
#define PHASE_ENTER() do { C.p = launder_kp(); C.ws = launder(C.p->ws); C.c = opaque_s((int)blockIdx.x); C.G = opaque_s((int)gridDim.x); { LAS unsigned char* l_ = lds; asm volatile("" : "+s"(l_)); C.lds = l_; } } while (0)

__device__ __forceinline__ void cvt_tile(LAS float* tl, const float* src, int ld_src, int c0, int k0, bf16_t* dst, int ldd, int n0) {
    const int tid = otid();
#pragma unroll
    for (int j = 0; j < 4; ++j) { const int r = (tid >> 4) + 32 * j, cc = (tid & 15) * 4;
        const f32x4 v = *(const f32x4*)(src + (size_t)(k0 + r) * ld_src + c0 + cc);
        tl[(cc + 0) * 129 + r] = v[0]; tl[(cc + 1) * 129 + r] = v[1]; tl[(cc + 2) * 129 + r] = v[2]; tl[(cc + 3) * 129 + r] = v[3]; }
    __syncthreads();
    { const int n = tid >> 3, ks = (tid & 7) * 16; const LAS float* rp = tl + n * 129 + ks;
      f32x4 a, b, c, d; a = (f32x4){rp[0], rp[1], rp[2], rp[3]}; b = (f32x4){rp[4], rp[5], rp[6], rp[7]}; c = (f32x4){rp[8], rp[9], rp[10], rp[11]}; d = (f32x4){rp[12], rp[13], rp[14], rp[15]};
      bf16_t* dp = dst + (size_t)(n0 + n) * ldd + k0 + ks;
      *(u32x4*)dp = pack8f(a, b); *(u32x4*)(dp + 8) = pack8f(c, d); }
    __syncthreads();
}
__device__ __forceinline__ unsigned pk4_fp8(float a, float b, float c, float d) { unsigned w = 0; w = __builtin_amdgcn_cvt_pk_fp8_f32(a, b, w, false); w = __builtin_amdgcn_cvt_pk_fp8_f32(c, d, w, true); return w; }
__device__ __forceinline__ void cvt_tile8(LAS float* tl, const float* src, int ld_src, int c0, int k0, unsigned char* dst, int ldd, int n0, float scale) {
    const int tid = otid();
#pragma unroll
    for (int j = 0; j < 4; ++j) { const int r = (tid >> 4) + 32 * j, cc = (tid & 15) * 4;
        const f32x4 v = *(const f32x4*)(src + (size_t)(k0 + r) * ld_src + c0 + cc);
        tl[(cc + 0) * 129 + r] = v[0]; tl[(cc + 1) * 129 + r] = v[1]; tl[(cc + 2) * 129 + r] = v[2]; tl[(cc + 3) * 129 + r] = v[3]; }
    __syncthreads();
    { const int n = tid >> 3, ks = (tid & 7) * 16; const LAS float* rp = tl + n * 129 + ks; u32x4 w;
      w.x = pk4_fp8(rp[0] * scale, rp[1] * scale, rp[2] * scale, rp[3] * scale); w.y = pk4_fp8(rp[4] * scale, rp[5] * scale, rp[6] * scale, rp[7] * scale);
      w.z = pk4_fp8(rp[8] * scale, rp[9] * scale, rp[10] * scale, rp[11] * scale); w.w = pk4_fp8(rp[12] * scale, rp[13] * scale, rp[14] * scale, rp[15] * scale);
      *(u32x4*)(dst + (size_t)(n0 + n) * ldd + k0 + ks) = w; }
    __syncthreads();
}
__device__ __forceinline__ void phase_prologue(const Ctx& C) {
    const int l = C.layer, tid = otid();
    LAS float* tl = (LAS float*)(C.lds + LDS_STAGE);
    constexpr int J_WIN = 220 * 16, J_C1 = 2 * 8 * 32, J_C2 = 4 * 4, J_BR = 32 * 24, J_OUT = 32 * 16, J_GU = 32 * 16 * 16, J_D = 32 * 32 * 4, J_PG = 32 * 16, J_PP = 32 * 2;
    constexpr int E0 = J_WIN, E1 = E0 + J_C1, E2 = E1 + J_C2, E3 = E2 + J_BR, E4 = E3 + J_OUT, E5 = E4 + J_GU, E6 = E5 + J_D, E7 = E6 + J_PG, E8 = E7 + J_PP;
    struct Job { const float* src; int ld, c0, k0; unsigned char* dst; int ldd, n0, f8; float scale; };
    auto decode = [&](int j, Job& J) {
        if (j < E0) { const int nt_ = j / 16, kc = j % 16; J.src = C.in(I_WIN) + (size_t)l * 2048 * IN_W; J.ld = IN_W; J.k0 = kc * 128;
            if (nt_ < 68) { const int n0 = ZCONF + nt_ * 64; const int w_ = n0 - (ZSC + 1024);
                J.c0 = n0 < ZSC ? n0 - ZCONF + 2584 : (n0 < ZSC + 1024 ? n0 - ZSC + 4632 : (n0 < ZG24 ? 5656 + ((w_ >> 7) & 1) * 1024 + (w_ >> 8) * 128 + (w_ & 127) : 2560)); J.dst = (unsigned char*)C.Win(); J.ldd = 2048; J.n0 = n0; J.f8 = 0; J.scale = 1.f; }
            else { const int n0 = (nt_ - 68) * 64; J.c0 = n0 < GCONF ? 7704 + n0 : (n0 < LDG ? 3608 + (n0 - GCONF) : n0 - LDG); J.dst = C.Wmg(); J.ldd = 2048; J.n0 = n0; J.f8 = 1; J.scale = 64.f; } }
        else if (j < E1) { const int q = j - E0, kv = q / 256, r = q % 256, nt_ = r / 32, kc = r % 32; J.src = C.in(I_W1) + (size_t)(l * 2 + kv) * 4096 * 512; J.ld = 512; J.c0 = nt_ * 64; J.k0 = kc * 128; J.dst = (unsigned char*)(C.Wc1() + (size_t)kv * 512 * 4096); J.ldd = 4096; J.n0 = nt_ * 64; J.f8 = 0; J.scale = 1.f; }
        else if (j < E2) { const int q = j - E1, nt_ = q / 4, kc = q % 4, kv = nt_ >> 1; J.src = C.in(I_W2) + (size_t)(l * 2 + kv) * 512 * 128; J.ld = 128; J.c0 = (nt_ & 1) * 64; J.k0 = kc * 128; J.dst = (unsigned char*)C.Wc2(); J.ldd = 512; J.n0 = nt_ * 64; J.f8 = 0; J.scale = 1.f; }
        else if (j < E3) { const int q = j - E2, nt_ = q / 24, kc = q % 24; J.src = C.in(I_WBR) + (size_t)l * 3072 * 2048; J.ld = 2048; J.c0 = nt_ * 64; J.k0 = kc * 128; J.dst = (unsigned char*)C.Wbr(); J.ldd = 3072; J.n0 = nt_ * 64; J.f8 = 0; J.scale = 1.f;
            if (kc < 16) { J.src += (size_t)(kc >> 3) * 1024 * 2048; J.k0 = (kc & 7) * 128; J.dst += kc < 8 ? 3072 : 2048; J.ldd = 6144; J.f8 = 1; J.scale = 64.f; } }
        else if (j < E4) { const int q = j - E3, nt_ = q / 16, kc = q % 16; J.src = C.in(I_WOUT) + (size_t)l * 2048 * 2048; J.ld = 2048; J.c0 = nt_ * 64; J.k0 = kc * 128; J.dst = (unsigned char*)C.Wout(); J.ldd = 2048; J.n0 = nt_ * 64; J.f8 = 0; J.scale = 1.f; }
        else if (j < E5) { const int q = j - E4, e = q / 256, r = q % 256, nt_ = r / 16, kc = r % 16, n0 = nt_ * 64; const int pn = n0 >> 8, bj = (n0 >> 7) & 1, i0 = n0 & 127;
            J.src = (bj ? C.in(I_WU) : C.in(I_WG)) + (size_t)(l * 32 + e) * 2048 * 512; J.ld = 512; J.c0 = pn * 128 + i0; J.k0 = kc * 128; J.dst = (unsigned char*)C.Wgu() + (size_t)e * 1024 * 2048; J.ldd = 2048; J.n0 = n0; J.f8 = 1; J.scale = 64.f; }
        else if (j < E6) { const int q = j - E5, e = q / 128, r = q % 128, nt_ = r / 4, kc = r % 4; J.src = C.in(I_WD) + (size_t)(l * 32 + e) * 512 * 2048; J.ld = 2048; J.c0 = nt_ * 64; J.k0 = kc * 128; J.dst = (unsigned char*)C.Wd() + (size_t)e * 2048 * 512; J.ldd = 512; J.n0 = nt_ * 64; J.f8 = 1; J.scale = 32.f; }
        else if (j < E7) { const int q = j - E6, nt_ = q / 16, kc = q % 16; J.src = C.in(I_PGW) + (size_t)l * 2048 * 2048; J.ld = 2048; J.c0 = nt_ * 64; J.k0 = kc * 128; J.dst = (unsigned char*)C.Wpg(); J.ldd = 2048; J.n0 = nt_ * 64; J.f8 = 1; J.scale = 64.f; }
        else { const int q = j - E7, nt_ = q / 2, kc = q % 2; J.src = C.in(I_PPW) + (size_t)l * 256 * 2048; J.ld = 2048; J.c0 = nt_ * 64; J.k0 = kc * 128; J.dst = (unsigned char*)C.Wpp(); J.ldd = 256; J.n0 = nt_ * 64; J.f8 = 0; J.scale = 1.f; }
    };
#define PRO_LOAD(buf, J) do { _Pragma("unroll") for (int q_ = 0; q_ < 4; ++q_) buf[q_] = *(const f32x4*)((J).src + (size_t)((J).k0 + (tid >> 4) + 32 * q_) * (J).ld + (J).c0 + (tid & 15) * 4); } while (0)
    { const int G = C.G; f32x4 b0[4], b1[4]; Job J0, J1, Jn; int par = 0;
      const int j0 = C.c; const bool has0 = j0 < E8, has1 = j0 + G < E8;
      if (has0) { decode(j0, J0); PRO_LOAD(b0, J0); }
      if (has1) { decode(j0 + G, J1); PRO_LOAD(b1, J1); }
      for (int j = j0; j < E8; j += G) {
          LAS float* t = tl + par * (64 * 129); par ^= 1;
          { const int cc = (tid & 15) * 4;
#pragma unroll
            for (int q_ = 0; q_ < 4; ++q_) { const int r = (tid >> 4) + 32 * q_; t[(cc + 0) * 129 + r] = b0[q_][0]; t[(cc + 1) * 129 + r] = b0[q_][1]; t[(cc + 2) * 129 + r] = b0[q_][2]; t[(cc + 3) * 129 + r] = b0[q_][3]; } }
          const Job Jc = J0;
          J0 = J1;
#pragma unroll
          for (int q_ = 0; q_ < 4; ++q_) b0[q_] = b1[q_];
          if (j + 2 * G < E8) { decode(j + 2 * G, Jn); J1 = Jn; PRO_LOAD(b1, J1); }
          __syncthreads();
          { const int n = tid >> 3, ks = (tid & 7) * 16; const LAS float* rp = t + n * 129 + ks; const float sc = Jc.scale;
            if (Jc.f8) { u32x4 w; w.x = pk4_fp8(rp[0] * sc, rp[1] * sc, rp[2] * sc, rp[3] * sc); w.y = pk4_fp8(rp[4] * sc, rp[5] * sc, rp[6] * sc, rp[7] * sc);
                w.z = pk4_fp8(rp[8] * sc, rp[9] * sc, rp[10] * sc, rp[11] * sc); w.w = pk4_fp8(rp[12] * sc, rp[13] * sc, rp[14] * sc, rp[15] * sc);
                *(u32x4*)(Jc.dst + (size_t)(Jc.n0 + n) * Jc.ldd + Jc.k0 + ks) = w; }
            else { const f32x4 a = (f32x4){rp[0], rp[1], rp[2], rp[3]}, b = (f32x4){rp[4], rp[5], rp[6], rp[7]}, c = (f32x4){rp[8], rp[9], rp[10], rp[11]}, d = (f32x4){rp[12], rp[13], rp[14], rp[15]};
                bf16_t* dp = (bf16_t*)Jc.dst + (size_t)(Jc.n0 + n) * Jc.ldd + Jc.k0 + ks; *(u32x4*)dp = pack8f(a, b); *(u32x4*)(dp + 8) = pack8f(c, d); } }
      }
      __syncthreads(); }
#undef PRO_LOAD
    { const float* rg = C.in(I_RGW) + (size_t)l * 2048 * 4; const float* re = C.in(I_REW) + (size_t)l * 2048 * 32;
      for (int i = C.c * NTHREADS + tid; i < 64 * 2048; i += C.G * NTHREADS) { const int n = i >> 11, k = i & 2047;
          const float v = (n < 4 ? rg[k * 4 + n] : (n < 36 ? re[k * 32 + (n - 4)] : 0.f)) * C.in(I_FNORM)[l * D + k];
          C.Wr()[(size_t)n * 2048 + k] = (bf16_t)(cvtpk(v, 0.f) & 0xffffu); } }
    { const float* ps = C.in(I_P) + (size_t)l * T * 256;
      for (size_t i = (size_t)(C.c * NTHREADS + tid) * 8; i < (size_t)T * 256; i += (size_t)C.G * NTHREADS * 8) {
          const f32x4 a = *(const f32x4*)(ps + i), b = *(const f32x4*)(ps + i + 4); *(u32x4*)(C.PB() + i) = pack8f(a, b); } }
    for (int it = C.c; it < 128; it += C.G) { const int kv = it >> 6, kc = it & 63; const float* pe = C.in(I_PE) + (size_t)(l * 2 + kv) * 4096 + kc * 64;
        const float* w1 = C.in(I_W1) + ((size_t)(l * 2 + kv) * 4096 + kc * 64) * 512; float s = 0.f;
        for (int k = 0; k < 64; ++k) s += pe[k] * w1[(size_t)k * 512 + tid];
        C.b1p()[(kv * 64 + kc) * 512 + tid] = s; }
    { unsigned zz = 0u; asm volatile("" : "+v"(zz));
      for (int i = C.c * NTHREADS + tid; i < 32 * LDZ / 8; i += C.G * NTHREADS) *(u32x4*)(C.Z() + (size_t)T * LDZ + (size_t)i * 8) = (u32x4){zz, zz, zz, zz}; }
}

template <int MODE, bool XBF>
__device__ __forceinline__ void phase_rmsnorm(const Ctx& C, const void* x, const float* g, bf16_t* h, unsigned char* h8, float* rsout = nullptr) {
    const int tid = otid(), wid = tid >> 6, lane = tid & 63;
    for (int row = C.c * 8 + wid; row < T; row += C.G * 8) {
        f32x4 v[8]; float s = 0.f;
#pragma unroll
        for (int j = 0; j < 8; ++j) {
            if constexpr (XBF) { const u32x2 a = *(const u32x2*)((const bf16_t*)x + (size_t)row * D + j * 256 + lane * 4); v[j] = (f32x4){bflo(a.x), bfhi(a.x), bflo(a.y), bfhi(a.y)}; }
            else v[j] = *(const f32x4*)((const float*)x + (size_t)row * D + j * 256 + lane * 4);
            s += v[j][0] * v[j][0] + v[j][1] * v[j][1] + v[j][2] * v[j][2] + v[j][3] * v[j][3]; }
        s = wave_sum(s); const float rs = 1.0f / sqrtf(s * (1.0f / D) + RMS_EPS);
        if (rsout && lane == 0) rsout[row] = rs;
#pragma unroll
        for (int j = 0; j < 8; ++j) { const f32x4 gv = *(const f32x4*)(g + j * 256 + lane * 4); const f32x4 y = v[j] * rs * gv;
            if constexpr (MODE & 2) *(unsigned*)(h8 + (size_t)row * D + j * 256 + lane * 4) = pk4_fp8(y[0], y[1], y[2], y[3]);
            if constexpr (MODE & 1) { u32x2 w; w.x = cvtpk(y[0], y[1]); w.y = cvtpk(y[2], y[3]); *(u32x2*)(h + (size_t)row * D + j * 256 + lane * 4) = w; } }
    }
}
__device__ __forceinline__ void phase_combine_norm(const Ctx& C, const float* g) {
    const int tid = otid(), wid = tid >> 6, lane = tid & 63;
    for (int row = C.c * 8 + wid; row < T; row += C.G * 8) {
        bf16_t* xr = C.XR() + (size_t)row * D; const unsigned char* y0 = (const unsigned char*)C.YB() + (size_t)(2 * row) * D; const unsigned char* y1 = y0 + D; f32x4 v[8]; float s = 0.f;
#pragma unroll
        for (int j = 0; j < 8; ++j) { const int col = j * 256 + lane * 4; { const u32x2 xw = *(const u32x2*)(xr + col); v[j] = (f32x4){bflo(xw.x), bfhi(xw.x), bflo(xw.y), bfhi(xw.y)}; } const unsigned a = *(const unsigned*)(y0 + col), b = *(const unsigned*)(y1 + col);
            const f32x2 al = __builtin_amdgcn_cvt_pk_f32_fp8(a, false), ah = __builtin_amdgcn_cvt_pk_f32_fp8(a, true), bl = __builtin_amdgcn_cvt_pk_f32_fp8(b, false), bh = __builtin_amdgcn_cvt_pk_f32_fp8(b, true);
            v[j][0] += al[0] + bl[0]; v[j][1] += al[1] + bl[1]; v[j][2] += ah[0] + bh[0]; v[j][3] += ah[1] + bh[1];
            { u32x2 w; w.x = cvtpk(v[j][0], v[j][1]); w.y = cvtpk(v[j][2], v[j][3]); *(u32x2*)(xr + col) = w; v[j] = (f32x4){bflo(w.x), bfhi(w.x), bflo(w.y), bfhi(w.y)}; }
            s += v[j][0] * v[j][0] + v[j][1] * v[j][1] + v[j][2] * v[j][2] + v[j][3] * v[j][3]; }
        s = wave_sum(s); const float rs = 1.0f / sqrtf(s * (1.0f / D) + RMS_EPS);
#pragma unroll
        for (int j = 0; j < 8; ++j) { const f32x4 gv = *(const f32x4*)(g + j * 256 + lane * 4); const f32x4 y = v[j] * rs * gv;
            *(unsigned*)(C.H8() + (size_t)row * D + j * 256 + lane * 4) = pk4_fp8(y[0], y[1], y[2], y[3]); }
    }
}
__device__ __forceinline__ void phase_final_norm(const Ctx& C, const float* g) {
    const int tid = otid(), wid = tid >> 6, lane = tid & 63;
    for (int row = C.c * 8 + wid; row < T; row += C.G * 8) {
        float* xr = C.x + (size_t)row * D; const bf16_t* xb = C.XR() + (size_t)row * D; f32x4 v[8]; float s = 0.f;
#pragma unroll
        for (int j = 0; j < 8; ++j) { const u32x2 a = *(const u32x2*)(xb + j * 256 + lane * 4); v[j] = (f32x4){bflo(a.x), bfhi(a.x), bflo(a.y), bfhi(a.y)}; s += v[j][0] * v[j][0] + v[j][1] * v[j][1] + v[j][2] * v[j][2] + v[j][3] * v[j][3]; }
        s = wave_sum(s); const float rs = 1.0f / sqrtf(s * (1.0f / D) + RMS_EPS);
#pragma unroll
        for (int j = 0; j < 8; ++j) { const f32x4 gv = *(const f32x4*)(g + j * 256 + lane * 4); *(f32x4*)(xr + j * 256 + lane * 4) = v[j] * rs * gv; }
    }
}

__device__ __forceinline__ void phase_conv(const Ctx& C) {
    const int l = C.layer, tid = otid(), wid = tid >> 6, lane = tid & 63;
    LAS bf16_t* ut = (LAS bf16_t*)(C.lds + LDS_STAGE);
    const float* cw = C.in(I_CCW) + (size_t)l * 31 * 1024; const float* cb = C.in(I_CCB) + (size_t)l * 1024;
    const float* lg = C.in(I_CLG) + (size_t)l * 1024; const float* lb = C.in(I_CLB) + (size_t)l * 1024; const float* sw = C.in(I_SCW) + (size_t)l * 3 * 1024;
    const int ntl = 0;
    for (int ti = 0; ti < (ntl ? ntl : (T / 32 - C.c + C.G - 1) / C.G); ++ti) {
        const int tile = ntl ? (C.c >= 128 ? (C.c - 128) * 3 + ti : 384 + C.c) : C.c + ti * C.G;
        const int tt0 = tile * 32, pos0 = tt0 & (SEQ - 1);
#pragma unroll 1
        for (int bt = 0; bt < 4; ++bt) { u32x4 av[4]; u32x2 gv8[4];
#pragma unroll
            for (int q = 0; q < 4; ++q) { const int it = tid + (bt * 4 + q) * NTHREADS, r = it >> 7, c8 = (it & 127) * 8; const bool ok = it < 62 * 128 && pos0 - 30 + r >= 0;
                const size_t rw = (size_t)(tt0 - 30 + (ok ? r : 30)); av[q] = *(const u32x4*)(C.Z() + rw * LDZ + ZCONF + c8); gv8[q] = *(const u32x2*)((const unsigned char*)C.GB() + rw * (LDG * 2) + GCONF + c8); }
#pragma unroll
            for (int q = 0; q < 4; ++q) { const int it = tid + (bt * 4 + q) * NTHREADS, r = it >> 7, c8 = (it & 127) * 8; const bool ok = pos0 - 30 + r >= 0;
                if (it < 62 * 128) { const u32x4 a = av[q]; const u32x2 gt = gv8[q]; u32x4 w; constexpr float k8 = 1.0f / 255.0f;
#define UB(w_, n_) ((float)(((w_) >> (8 * (n_))) & 0xffu) * k8)
                    w.x = cvtpk(bflo(a.x) * UB(gt.x, 0), bfhi(a.x) * UB(gt.x, 1)); w.y = cvtpk(bflo(a.y) * UB(gt.x, 2), bfhi(a.y) * UB(gt.x, 3));
                    w.z = cvtpk(bflo(a.z) * UB(gt.y, 0), bfhi(a.z) * UB(gt.y, 1)); w.w = cvtpk(bflo(a.w) * UB(gt.y, 2), bfhi(a.w) * UB(gt.y, 3));
#undef UB
                    if (!ok) { unsigned zz = 0u; asm volatile("" : "+v"(zz)); w = (u32x4){zz, zz, zz, zz}; }
                    *(LAS u32x4*)(ut + r * 1024 + c8) = w; } } }
        __syncthreads();
        const int c0 = lane * 16;
#define CH(j) (((j) >> 1) * 512 + lane * 8 + ((j) & 1) * 4)
        float acc[4][16];
#pragma unroll
        for (int j = 0; j < 4; ++j) { const f32x4 b = *(const f32x4*)(cb + CH(j));
#pragma unroll
            for (int i = 0; i < 4; ++i) { acc[i][j * 4 + 0] = b[0]; acc[i][j * 4 + 1] = b[1]; acc[i][j * 4 + 2] = b[2]; acc[i][j * 4 + 3] = b[3]; } }
        f32x4 wn[4];
#pragma unroll
        for (int j = 0; j < 4; ++j) wn[j] = *(const f32x4*)(cw + CH(j));
#pragma unroll 2
        for (int k = 0; k < 31; ++k) {
            float wv[16];
#pragma unroll
            for (int j = 0; j < 4; ++j) { wv[j * 4] = wn[j][0]; wv[j * 4 + 1] = wn[j][1]; wv[j * 4 + 2] = wn[j][2]; wv[j * 4 + 3] = wn[j][3]; }
            { const int kn = k + 1 < 31 ? k + 1 : 30;
#pragma unroll
              for (int j = 0; j < 4; ++j) wn[j] = *(const f32x4*)(cw + (size_t)kn * 1024 + CH(j)); }
#pragma unroll
            for (int i = 0; i < 4; ++i) { const LAS bf16_t* up = ut + (wid * 4 + i + k) * 1024 + lane * 8; const u32x4 u0 = *(const LAS u32x4*)up, u1 = *(const LAS u32x4*)(up + 512);
                acc[i][0] += wv[0] * bflo(u0.x); acc[i][1] += wv[1] * bfhi(u0.x); acc[i][2] += wv[2] * bflo(u0.y); acc[i][3] += wv[3] * bfhi(u0.y);
                acc[i][4] += wv[4] * bflo(u0.z); acc[i][5] += wv[5] * bfhi(u0.z); acc[i][6] += wv[6] * bflo(u0.w); acc[i][7] += wv[7] * bfhi(u0.w);
                acc[i][8] += wv[8] * bflo(u1.x); acc[i][9] += wv[9] * bfhi(u1.x); acc[i][10] += wv[10] * bflo(u1.y); acc[i][11] += wv[11] * bfhi(u1.y);
                acc[i][12] += wv[12] * bflo(u1.z); acc[i][13] += wv[13] * bfhi(u1.z); acc[i][14] += wv[14] * bflo(u1.w); acc[i][15] += wv[15] * bfhi(u1.w); }
        }
        float gv[16], bv[16];
#pragma unroll
        for (int j = 0; j < 4; ++j) { const f32x4 a = *(const f32x4*)(lg + CH(j)), b = *(const f32x4*)(lb + CH(j));
            gv[j * 4] = a[0]; gv[j * 4 + 1] = a[1]; gv[j * 4 + 2] = a[2]; gv[j * 4 + 3] = a[3]; bv[j * 4] = b[0]; bv[j * 4 + 1] = b[1]; bv[j * 4 + 2] = b[2]; bv[j * 4 + 3] = b[3]; }
#pragma unroll
        for (int i = 0; i < 4; ++i) { float s = 0.f;
#pragma unroll
            for (int j = 0; j < 16; ++j) s += acc[i][j];
            s = wave_sum(s); const float mean = s * (1.0f / 1024.0f); float q = 0.f;
#pragma unroll
            for (int j = 0; j < 16; ++j) { const float d = acc[i][j] - mean; q += d * d; }
            q = wave_sum(q); const float rs = 1.0f / sqrtf(q * (1.0f / 1024.0f) + RMS_EPS);
            float y[16];
#pragma unroll
            for (int j = 0; j < 16; ++j) y[j] = siluf_((acc[i][j] - mean) * rs * gv[j] + bv[j]);
            unsigned char* op = (unsigned char*)C.OB() + (size_t)(tt0 + wid * 4 + i) * 6144 + 2048 + lane * 8;
            u32x2 w0, w1; w0.x = pk4_fp8(y[0], y[1], y[2], y[3]); w0.y = pk4_fp8(y[4], y[5], y[6], y[7]); w1.x = pk4_fp8(y[8], y[9], y[10], y[11]); w1.y = pk4_fp8(y[12], y[13], y[14], y[15]);
            *(u32x2*)op = w0; *(u32x2*)(op + 512) = w1; }
#undef CH
        { float w3[3][16];
#pragma unroll
          for (int k = 0; k < 3; ++k)
#pragma unroll
              for (int j = 0; j < 4; ++j) { const f32x4 a = *(const f32x4*)(sw + k * 1024 + c0 + j * 4); w3[k][j * 4] = a[0]; w3[k][j * 4 + 1] = a[1]; w3[k][j * 4 + 2] = a[2]; w3[k][j * 4 + 3] = a[3]; }
          const int t0_ = tt0 + wid * 4, pos0_ = t0_ & (SEQ - 1); u32x4 cr[6][2];
#pragma unroll
          for (int r = 0; r < 6; ++r) { const bool ok = pos0_ - 2 + r >= 0; const bf16_t* zp = C.Z() + (size_t)(t0_ - 2 + (ok ? r : 2)) * LDZ + ZSC + 1024 + c0;
              cr[r][0] = *(const u32x4*)zp; cr[r][1] = *(const u32x4*)(zp + 8);
              if (!ok) { unsigned zz = 0u; asm volatile("" : "+v"(zz)); cr[r][0] = (u32x4){zz, zz, zz, zz}; cr[r][1] = (u32x4){zz, zz, zz, zz}; } }
#pragma unroll
          for (int i = 0; i < 4; ++i) { const int t = tt0 + wid * 4 + i; float a[16];
#pragma unroll
              for (int j = 0; j < 16; ++j) a[j] = 0.f;
#pragma unroll
              for (int k = 0; k < 3; ++k) { const u32x4 g0 = cr[i + k][0], g1 = cr[i + k][1];
                  a[0] += w3[k][0] * bflo(g0.x); a[1] += w3[k][1] * bfhi(g0.x); a[2] += w3[k][2] * bflo(g0.y); a[3] += w3[k][3] * bfhi(g0.y);
                  a[4] += w3[k][4] * bflo(g0.z); a[5] += w3[k][5] * bfhi(g0.z); a[6] += w3[k][6] * bflo(g0.w); a[7] += w3[k][7] * bfhi(g0.w);
                  a[8] += w3[k][8] * bflo(g1.x); a[9] += w3[k][9] * bfhi(g1.x); a[10] += w3[k][10] * bflo(g1.y); a[11] += w3[k][11] * bfhi(g1.y);
                  a[12] += w3[k][12] * bflo(g1.z); a[13] += w3[k][13] * bfhi(g1.z); a[14] += w3[k][14] * bflo(g1.w); a[15] += w3[k][15] * bfhi(g1.w); }
              const bf16_t* bp = C.Z() + (size_t)t * LDZ + ZSC + c0; const u32x4 b0 = *(const u32x4*)bp, b1 = *(const u32x4*)(bp + 8);
u32x4 w0, w1; w0.x = cvtpk(a[0] * bflo(b0.x), a[1] * bfhi(b0.x)); w0.y = cvtpk(a[2] * bflo(b0.y), a[3] * bfhi(b0.y)); w0.z = cvtpk(a[4] * bflo(b0.z), a[5] * bfhi(b0.z)); w0.w = cvtpk(a[6] * bflo(b0.w), a[7] * bfhi(b0.w));
              w1.x = cvtpk(a[8] * bflo(b1.x), a[9] * bfhi(b1.x)); w1.y = cvtpk(a[10] * bflo(b1.y), a[11] * bfhi(b1.y)); w1.z = cvtpk(a[12] * bflo(b1.z), a[13] * bfhi(b1.z)); w1.w = cvtpk(a[14] * bflo(b1.w), a[15] * bfhi(b1.w));
              bf16_t* op = C.OB() + (size_t)t * 3072 + 2048 + c0; *(u32x4*)op = w0; *(u32x4*)(op + 8) = w1; } }
        __syncthreads();
    }
}

using pg8::Unit;
#define EPI_BEGIN _Pragma("unroll") for (int ai = 0; ai < 2; ++ai) _Pragma("unroll") for (int m = 0; m < 4; ++m) { const int rl = ai * 128 + wr * 64 + m * 16 + fr;
#define EPI_END asm volatile("" ::: "memory"); __builtin_amdgcn_sched_barrier(0); }
struct PlainBase {
    static constexpr bool A_PER_UNIT = false, FP8 = false;
    const bf16_t* A; const bf16_t* Bt; int lda, ldb_, nM, nN, ntk, G, c;
    __device__ __forceinline__ bool next(int i, Unit& u) const { return pg8::static_unit(i * G + c, nM, nN, u); }
    __device__ __forceinline__ int nt(const Unit&) const { return ntk; }
    __device__ __forceinline__ const char* a_base(const Unit& u) const { return (const char*)(A + (size_t)u.pm * 256 * lda); }
    __device__ __forceinline__ unsigned a_off(const Unit&, int, int R, int Cc) const { return (unsigned)(R * lda + Cc) * 2u; }
    __device__ __forceinline__ size_t a_hofs() const { return (size_t)128 * lda * 2; }
    __device__ __forceinline__ size_t a_kofs(int kt) const { return (size_t)kt * 128; }
    __device__ __forceinline__ const char* b_base(const Unit& u) const { return (const char*)(Bt + (size_t)u.pn * 256 * ldb_); }
    __device__ __forceinline__ int ldb() const { return ldb_; }
};
template <bool F8>
struct ProbInT : PlainBase {
    static constexpr bool FP8 = F8;
    bf16_t* O; int ldo; bf16_t* O2; int ldo2, n1;
    __device__ __forceinline__ bool next(int i, Unit& u) const {
        if (!F8) return pg8::static_unit(i * G + c, nM, nN, u);
        if (G != 256 || nN != 38) return pg8::static_unit(i * G + (G - 1 - c), nM, nN, u);
        if (i < 8) return pg8::static_unit(i * 256 + c, nM, nN, u);
        if (c < 64 || i >= 10) return false;
        return pg8::static_unit(2048 + (i - 8) * 192 + (c - 64), nM, nN, u); }
    __device__ __forceinline__ void epi(const Acc& acc, const Unit& u, int wr, int wc, int fr, int fq) const {
        const bool second = F8 && u.pn >= n1;
        const int col0 = (second ? u.pn - n1 : u.pn) * 256 + wc * 32 + fq * 8; const bool sg = F8 ? (opaque_s0(1) != 0 && !second) : (opaque_s0(0) != 0 || u.pn == (ZG24 - ZCONF) / 256);
        bf16_t* Ob = second ? O2 : O; const int ldo_ = second ? ldo2 : ldo;
        const bool cxt = !F8 && u.pn >= (ZSC + 1024 - ZCONF) / 256 && u.pn < (ZG24 - ZCONF) / 256;
        const bool g8 = F8 && !second;
        EPI_BEGIN { bf16_t* rp = Ob + (size_t)(u.pm * 256 + rl) * ldo_ + col0;
            if (cxt) { *(u32x4*)(O + (size_t)(u.pm * 256 + rl) * ldo + (ZSC + 1024 - ZCONF) + (u.pn - (ZSC + 1024 - ZCONF) / 256) * 128 + wc * 32 + fq * 8) = pack8f(acc[ai][0][m][0] * acc[ai][1][m][0], acc[ai][0][m][1] * acc[ai][1][m][1]); }
            else
#pragma unroll
            for (int bj = 0; bj < 2; ++bj) { f32x4 v0 = acc[ai][bj][m][0], v1 = acc[ai][bj][m][1];
                if (sg) {
#pragma unroll
                    for (int j = 0; j < 4; ++j) { v0[j] = sigmoidf_(v0[j] * (F8 ? 1.0f / 64.0f : 1.0f)); v1[j] = sigmoidf_(v1[j] * (F8 ? 1.0f / 64.0f : 1.0f)); } }
                else if (F8) { v0 *= 1.0f / 64.0f; v1 *= 1.0f / 64.0f; }
                if (g8) { u32x2 w;
                    w.x = (unsigned)(v0[0] * 255.f + 0.5f) | ((unsigned)(v0[1] * 255.f + 0.5f) << 8) | ((unsigned)(v0[2] * 255.f + 0.5f) << 16) | ((unsigned)(v0[3] * 255.f + 0.5f) << 24);
                    w.y = (unsigned)(v1[0] * 255.f + 0.5f) | ((unsigned)(v1[1] * 255.f + 0.5f) << 8) | ((unsigned)(v1[2] * 255.f + 0.5f) << 16) | ((unsigned)(v1[3] * 255.f + 0.5f) << 24);
                    *(u32x2*)((unsigned char*)O + (size_t)(u.pm * 256 + rl) * (ldo * 2) + col0 + bj * 128) = w; }
                else *(u32x4*)(rp + bj * 128) = pack8f(v0, v1); } } EPI_END
    }
};
struct ProbC1 {
    static constexpr bool A_PER_UNIT = false; static constexpr int FP8 = 0;
    const bf16_t* Z; const bf16_t* Wc1; float* slab; int c;
    __device__ __forceinline__ bool next(int i, Unit& u) const { if (i > 0 || c >= 256) return false; u.aux = c & 7; u.pm = c >> 4; u.pn = (c >> 3) & 1; return true; }
    __device__ __forceinline__ int nt(const Unit&) const { return 8; }
    __device__ __forceinline__ const char* a_base(const Unit& u) const { const int kv = u.pm >> 3, bg = u.pm & 7, b = bg >> 1, g = bg & 1; return (const char*)(Z + (size_t)(b * SEQ + u.aux * 4) * LDZ + ZKV + kv * 256 + g * 128); }
    __device__ __forceinline__ unsigned a_off(const Unit&, int, int R, int Cc) const { return (unsigned)(R * 16 * LDZ + Cc) * 2u; }
    __device__ __forceinline__ size_t a_hofs() const { return (size_t)128 * 16 * LDZ * 2; }
    __device__ __forceinline__ size_t a_kofs(int kt) const { return ((size_t)(kt >> 1) * LDZ + (size_t)(kt & 1) * 64) * 2; }
    __device__ __forceinline__ const char* b_base(const Unit& u) const { return (const char*)(Wc1 + ((size_t)(u.pm >> 3) * 512 + (size_t)u.pn * 256) * 4096 + u.aux * 512); }
    __device__ __forceinline__ int ldb() const { return 4096; }
    __device__ __forceinline__ void epi(const Acc& acc, const Unit& u, int wr, int wc, int fr, int fq) const {
        const int col0 = u.pn * 256 + wc * 32 + fq * 8; float* sp = slab + (size_t)u.aux * 4096 * 512;
        EPI_BEGIN { float* rp = sp + (size_t)(u.pm * 256 + rl) * 512 + col0;
#pragma unroll
            for (int bj = 0; bj < 2; ++bj) { *(f32x4*)(rp + bj * 128) = acc[ai][bj][m][0]; *(f32x4*)(rp + bj * 128 + 4) = acc[ai][bj][m][1]; } } EPI_END
    }
};
__device__ __forceinline__ void phase_c1_reduce(const Ctx& C, const float* slab) {
    const int tid = otid();
    for (int it = C.c * NTHREADS + tid; it < 4096 * 64; it += C.G * NTHREADS) { const int row = it >> 6, c8 = (it & 63) * 8, kv = row >> 11;
        const float* sp = slab + (size_t)row * 512 + c8; const float* bp = C.b1() + kv * 512 + c8;
        f32x4 a = *(const f32x4*)bp, b = *(const f32x4*)(bp + 4);
#pragma unroll
        for (int ks = 0; ks < 8; ++ks) { a += *(const f32x4*)(sp + (size_t)ks * 4096 * 512); b += *(const f32x4*)(sp + (size_t)ks * 4096 * 512 + 4); }
#pragma unroll
        for (int j = 0; j < 4; ++j) { a[j] = gelu_tanh(a[j]); b[j] = gelu_tanh(b[j]); }
        *(u32x4*)(C.HID() + (size_t)row * 512 + c8) = pack8f(a, b); }
}
struct ProbC2 : PlainBase {
    bf16_t* KC; bf16_t* VC;
    __device__ __forceinline__ bool next(int i, Unit& u) const { if (i > 0 || c >= 16) return false; u.pm = c; u.pn = 0; u.aux = 0; return true; }
    __device__ __forceinline__ void epi(const Acc& acc, const Unit& u, int wr, int wc, int fr, int fq) const {
        const int kv = u.pm >> 3; bf16_t* dst = (kv ? VC : KC) + (size_t)(u.pm & 7) * 256 * 128 + wc * 32 + fq * 8;
        EPI_BEGIN { const f32x4 v0 = kv ? acc[ai][1][m][0] : acc[ai][0][m][0], v1 = kv ? acc[ai][1][m][1] : acc[ai][0][m][1]; *(u32x4*)(dst + (size_t)rl * 128) = pack8f(v0, v1); } EPI_END
    }
};
template <bool F8>
struct ProbBr {
    static constexpr bool A_PER_UNIT = false, FP8 = F8;
    const bf16_t* OB; const bf16_t* Wbr; const bf16_t* Z; bf16_t* MRG; int G, c;
    __device__ __forceinline__ bool next(int i, Unit& u) const { const int ui = F8 ? i >> 1 : i; if (!pg8::static_unit(ui * G + c, 64, 8, u)) return false; u.aux = F8 ? 1 - (i & 1) : 2; return true; }
    __device__ __forceinline__ int nt(const Unit&) const { return F8 ? 8 : 16; }
    __device__ __forceinline__ const char* a_base(const Unit& u) const { return (const char*)OB + (size_t)u.pm * 256 * 6144 + (F8 ? 3072 - u.aux * 1024 : 4096); }
    __device__ __forceinline__ unsigned a_off(const Unit&, int, int R, int Cc) const { return (unsigned)(R * 3072 + Cc) * 2u; }
    __device__ __forceinline__ size_t a_hofs() const { return (size_t)128 * 3072 * 2; }
    __device__ __forceinline__ size_t a_kofs(int kt) const { return (size_t)kt * 128; }
    __device__ __forceinline__ const char* b_base(const Unit& u) const { return (const char*)Wbr + (size_t)u.pn * 256 * 6144 + (F8 ? 3072 - u.aux * 1024 : 4096); }
    __device__ __forceinline__ int ldb() const { return 3072; }
    __device__ __forceinline__ void epi(const Acc& acc, const Unit& u, int wr, int wc, int fr, int fq) const {
        const int col0 = u.pn * 256 + wc * 32 + fq * 8; constexpr bool rmw = F8; const float sc = (F8 ? (u.aux ? 1.0f / 64.0f : 1.0f / 1024.0f) : 1.0f) * (1.0f / 255.0f);
        const unsigned char* gp0 = (const unsigned char*)Z + (size_t)(u.pm * 256 + wr * 64 + fr) * (LDG * 2) + u.aux * 2048 + col0;
        bf16_t* mp0 = MRG + (size_t)(u.pm * 256 + wr * 64 + fr) * 2048 + col0;
        u32x2 gw[2][2]; u32x4 pw[2][2];
#define BR_LOAD(r) do { const int ro_ = ((r) >> 2) * 128 + ((r) & 3) * 16; gw[(r) & 1][0] = *(const u32x2*)(gp0 + (size_t)ro_ * (LDG * 2)); gw[(r) & 1][1] = *(const u32x2*)(gp0 + (size_t)ro_ * (LDG * 2) + 128); \
        if (rmw) { pw[(r) & 1][0] = *(const u32x4*)(mp0 + (size_t)ro_ * 2048); pw[(r) & 1][1] = *(const u32x4*)(mp0 + (size_t)ro_ * 2048 + 128); } } while (0)
        BR_LOAD(0);
#pragma unroll
        for (int r = 0; r < 8; ++r) { const int ai = r >> 2, m = r & 3;
            if (r + 1 < 8) BR_LOAD(r + 1);
            bf16_t* mp = mp0 + (size_t)(ai * 128 + m * 16) * 2048;
#pragma unroll
            for (int bj = 0; bj < 2; ++bj) { const u32x2 g = gw[r & 1][bj]; f32x4 v0 = acc[ai][bj][m][0] * sc, v1 = acc[ai][bj][m][1] * sc;
                v0[0] *= (float)((g.x >> 0) & 0xffu); v0[1] *= (float)((g.x >> 8) & 0xffu); v0[2] *= (float)((g.x >> 16) & 0xffu); v0[3] *= (float)((g.x >> 24) & 0xffu);
                v1[0] *= (float)((g.y >> 0) & 0xffu); v1[1] *= (float)((g.y >> 8) & 0xffu); v1[2] *= (float)((g.y >> 16) & 0xffu); v1[3] *= (float)((g.y >> 24) & 0xffu);
                if (rmw) { const u32x4 q = pw[r & 1][bj];
                    v0[0] += bflo(q.x); v0[1] += bfhi(q.x); v0[2] += bflo(q.y); v0[3] += bfhi(q.y); v1[0] += bflo(q.z); v1[1] += bfhi(q.z); v1[2] += bflo(q.w); v1[3] += bfhi(q.w); }
                *(u32x4*)(mp + bj * 128) = pack8f(v0, v1); }
            asm volatile("" ::: "memory"); __builtin_amdgcn_sched_barrier(0); }
#undef BR_LOAD
    }
};
template <bool XBF>
struct ProbOut : PlainBase {
    const void* xin; bf16_t* xout;
    __device__ __forceinline__ void epi(const Acc& acc, const Unit& u, int wr, int wc, int fr, int fq) const {
        const size_t o0 = (size_t)(u.pm * 256 + wr * 64 + fr) * D + u.pn * 256 + wc * 32 + fq * 8;
        f32x4 xv[2][4]; u32x4 xb[2][2];
#define OUT_LOAD(r) do { const size_t o_ = o0 + (size_t)(((r) >> 2) * 128 + ((r) & 3) * 16) * D; \
        if constexpr (XBF) { xb[(r) & 1][0] = *(const u32x4*)((const bf16_t*)xin + o_); xb[(r) & 1][1] = *(const u32x4*)((const bf16_t*)xin + o_ + 128); } \
        else { xv[(r) & 1][0] = *(const f32x4*)((const float*)xin + o_); xv[(r) & 1][1] = *(const f32x4*)((const float*)xin + o_ + 4); \
               xv[(r) & 1][2] = *(const f32x4*)((const float*)xin + o_ + 128); xv[(r) & 1][3] = *(const f32x4*)((const float*)xin + o_ + 132); } } while (0)
        OUT_LOAD(0);
#pragma unroll
        for (int r = 0; r < 8; ++r) { const int ai = r >> 2, m = r & 3;
            if (r + 1 < 8) OUT_LOAD(r + 1);
            bf16_t* op = xout + o0 + (size_t)(ai * 128 + m * 16) * D;
#pragma unroll
            for (int bj = 0; bj < 2; ++bj) { f32x4 a, b;
                if constexpr (XBF) { const u32x4 w = xb[r & 1][bj]; a = (f32x4){bflo(w.x), bfhi(w.x), bflo(w.y), bfhi(w.y)}; b = (f32x4){bflo(w.z), bfhi(w.z), bflo(w.w), bfhi(w.w)}; }
                else { a = xv[r & 1][2 * bj]; b = xv[r & 1][2 * bj + 1]; }
                *(u32x4*)(op + bj * 128) = pack8f(a + acc[ai][bj][m][0], b + acc[ai][bj][m][1]); }
            asm volatile("" ::: "memory"); __builtin_amdgcn_sched_barrier(0); }
#undef OUT_LOAD
    }
};
struct ProbRt : PlainBase {
    float* LOG;
    __device__ __forceinline__ bool next(int i, Unit& u) const { if (i > 0 || c >= 256) return false; u.pm = c >> 2; u.pn = 0; u.aux = c & 3; return true; }
    __device__ __forceinline__ const char* a_base(const Unit& u) const { return (const char*)(A + (size_t)u.pm * 256 * lda + u.aux * 512); }
    __device__ __forceinline__ const char* b_base(const Unit& u) const { return (const char*)(Bt + u.aux * 512); }
    __device__ __forceinline__ void epi(const Acc& acc, const Unit& u, int wr, int wc, int fr, int fq) const {
        if (wc >= 2) return; const int col0 = wc * 32 + fq * 8; float* sl = LOG + (size_t)u.aux * T * 64;
        EPI_BEGIN { float* lp = sl + (size_t)(u.pm * 256 + rl) * 64 + col0; *(f32x4*)lp = acc[ai][0][m][0]; *(f32x4*)(lp + 4) = acc[ai][0][m][1]; } EPI_END
    }
};
struct ProbUp {
    static constexpr bool A_PER_UNIT = true, FP8 = true;
    const unsigned char* H8; const unsigned char* Wgu; unsigned char* HE; const int* stok; const int* texp; int ntile, G, c;
    __device__ __forceinline__ bool next(int i, Unit& u) const { const int L = i * G + c; if (L >= ntile * 4) return false; u.pm = L >> 2; u.pn = L & 3; u.aux = __builtin_amdgcn_readfirstlane(texp[u.pm]); return true; }
    __device__ __forceinline__ int nt(const Unit&) const { return 16; }
    __device__ __forceinline__ const char* a_base(const Unit&) const { return (const char*)H8; }
    __device__ __forceinline__ unsigned a_off(const Unit& u, int h, int R, int Cc) const { return (unsigned)(stok[u.pm * 256 + h * 128 + R] * 1024 + Cc) * 2u; }
    __device__ __forceinline__ size_t a_hofs() const { return 0; }
    __device__ __forceinline__ size_t a_kofs(int kt) const { return (size_t)kt * 128; }
    __device__ __forceinline__ const char* b_base(const Unit& u) const { return (const char*)(Wgu + ((size_t)u.aux * 1024 + (size_t)u.pn * 256) * 2048); }
    __device__ __forceinline__ int ldb() const { return 1024; }
    __device__ __forceinline__ void epi(const Acc& acc, const Unit& u, int wr, int wc, int fr, int fq) const {
        const int col0 = u.pn * 128 + wc * 32 + fq * 8;
        EPI_BEGIN { f32x4 v0, v1;
#pragma unroll
            for (int j = 0; j < 4; ++j) { v0[j] = siluf_(acc[ai][0][m][0][j] * (1.0f / 64.0f)) * (acc[ai][1][m][0][j] * (1.0f / 64.0f)); v1[j] = siluf_(acc[ai][0][m][1][j] * (1.0f / 64.0f)) * (acc[ai][1][m][1][j] * (1.0f / 64.0f)); }
            u32x2 w; w.x = pk4_fp8(v0[0], v0[1], v0[2], v0[3]); w.y = pk4_fp8(v1[0], v1[1], v1[2], v1[3]);
            *(u32x2*)(HE + (size_t)(u.pm * 256 + rl) * 512 + col0) = w; } EPI_END
    }
};
struct ProbDn {
    static constexpr bool A_PER_UNIT = false, FP8 = true;
    const unsigned char* HE; const unsigned char* Wd; bf16_t* YB; const int* sdst; const float* sw; const int* texp; int ntile, G, c;
    __device__ __forceinline__ bool next(int i, Unit& u) const { const int L = i * G + c; if (L >= ntile * 8) return false; u.pm = L >> 3; u.pn = L & 7; u.aux = __builtin_amdgcn_readfirstlane(texp[u.pm]); return true; }
    __device__ __forceinline__ int nt(const Unit&) const { return 4; }
    __device__ __forceinline__ const char* a_base(const Unit& u) const { return (const char*)(HE + (size_t)u.pm * 256 * 512); }
    __device__ __forceinline__ unsigned a_off(const Unit&, int, int R, int Cc) const { return (unsigned)(R * 256 + Cc) * 2u; }
    __device__ __forceinline__ size_t a_hofs() const { return (size_t)128 * 512; }
    __device__ __forceinline__ size_t a_kofs(int kt) const { return (size_t)kt * 128; }
    __device__ __forceinline__ const char* b_base(const Unit& u) const { return (const char*)(Wd + ((size_t)u.aux * 2048 + (size_t)u.pn * 256) * 512); }
    __device__ __forceinline__ int ldb() const { return 256; }
    __device__ __forceinline__ void epi(const Acc& acc, const Unit& u, int wr, int wc, int fr, int fq) const {
        const int col0 = u.pn * 256 + wc * 32 + fq * 8;
        int dsts[8]; float ws[8];
#pragma unroll
        for (int r = 0; r < 8; ++r) { const int slot = u.pm * 256 + (r >> 2) * 128 + wr * 64 + (r & 3) * 16 + fr; dsts[r] = sdst[slot]; ws[r] = sw[slot] * (1.0f / 32.0f); }
        EPI_BEGIN { const int dst = dsts[ai * 4 + m]; const float w = ws[ai * 4 + m]; (void)rl;
            unsigned char* yp = (unsigned char*)YB + (size_t)dst * 2048 + col0;
#pragma unroll
            for (int bj = 0; bj < 2; ++bj) { const f32x4 a = acc[ai][bj][m][0] * w, b = acc[ai][bj][m][1] * w; u32x2 q; q.x = pk4_fp8(a[0], a[1], a[2], a[3]); q.y = pk4_fp8(b[0], b[1], b[2], b[3]); *(u32x2*)(yp + bj * 128) = q; } } EPI_END
    }
};
struct ProbPp : PlainBase {
    bf16_t* PP;
    __device__ __forceinline__ void epi(const Acc& acc, const Unit& u, int wr, int wc, int fr, int fq) const {
        const int col0 = u.pn * 256 + wc * 32 + fq * 8;
        EPI_BEGIN { bf16_t* rp = PP + (size_t)(u.pm * 256 + rl) * 2048 + col0;
#pragma unroll
            for (int bj = 0; bj < 2; ++bj) *(u32x4*)(rp + bj * 128) = pack8f(acc[ai][bj][m][0], acc[ai][bj][m][1]); } EPI_END
    }
};
struct ProbPg : PlainBase {
    static constexpr bool FP8 = true;
    const bf16_t* PP; bf16_t* x;
    __device__ __forceinline__ void epi(const Acc& acc, const Unit& u, int wr, int wc, int fr, int fq) const {
        const size_t o0 = (size_t)(u.pm * 256 + wr * 64 + fr) * D + u.pn * 256 + wc * 32 + fq * 8;
        u32x4 xb[2][2], pv[2][2];
#define PG_LOAD(r) do { const size_t o_ = o0 + (size_t)(((r) >> 2) * 128 + ((r) & 3) * 16) * D; xb[(r) & 1][0] = *(const u32x4*)(x + o_); xb[(r) & 1][1] = *(const u32x4*)(x + o_ + 128); \
        pv[(r) & 1][0] = *(const u32x4*)(PP + o_); pv[(r) & 1][1] = *(const u32x4*)(PP + o_ + 128); } while (0)
        PG_LOAD(0);
#pragma unroll
        for (int r = 0; r < 8; ++r) { const int ai = r >> 2, m = r & 3;
            if (r + 1 < 8) PG_LOAD(r + 1);
            bf16_t* op = x + o0 + (size_t)(ai * 128 + m * 16) * D;
#pragma unroll
            for (int bj = 0; bj < 2; ++bj) { const u32x4 pw = pv[r & 1][bj], xw = xb[r & 1][bj]; f32x4 a = (f32x4){bflo(xw.x), bfhi(xw.x), bflo(xw.y), bfhi(xw.y)}, b = (f32x4){bflo(xw.z), bfhi(xw.z), bflo(xw.w), bfhi(xw.w)};
                const f32x4 g0 = acc[ai][bj][m][0] * (1.0f / 64.0f), g1 = acc[ai][bj][m][1] * (1.0f / 64.0f);
                a[0] += sigmoidf_(g0[0]) * bflo(pw.x); a[1] += sigmoidf_(g0[1]) * bfhi(pw.x); a[2] += sigmoidf_(g0[2]) * bflo(pw.y); a[3] += sigmoidf_(g0[3]) * bfhi(pw.y);
                b[0] += sigmoidf_(g1[0]) * bflo(pw.z); b[1] += sigmoidf_(g1[1]) * bfhi(pw.z); b[2] += sigmoidf_(g1[2]) * bflo(pw.w); b[3] += sigmoidf_(g1[3]) * bfhi(pw.w);
                *(u32x4*)(op + bj * 128) = pack8f(a, b); }
            asm volatile("" ::: "memory"); __builtin_amdgcn_sched_barrier(0); }
#undef PG_LOAD
    }
};

__device__ __forceinline__ void phase_route(const Ctx& C) {
    const int l = C.layer, tid = otid();
    const float* rgb = C.in(I_RGB) + l * 4; const float* reb = C.in(I_REB) + l * 32; unsigned* cnt = C.ctl() + CW_CNT + l * 64;
    for (int i = C.c * NTHREADS + tid; i < NSLOT; i += C.G * NTHREADS) { C.stok()[i] = 0; C.sdst()[i] = 2 * T; C.sw()[i] = 0.f; }
    LAS unsigned* lc = (LAS unsigned*)(C.lds + LDS_MISC + 512);
    if (tid < 32) lc[tid] = 0u;
    __syncthreads();
    for (int t = C.c * NTHREADS + tid; t < T; t += C.G * NTHREADS) {
        const float* lp = C.LOG() + (size_t)t * 64; float gl[4]; const float rs = C.RS()[t];
#pragma unroll
        for (int j = 0; j < 4; ++j) gl[j] = ((lp[j] + lp[j + T * 64]) + (lp[j + 2 * T * 64] + lp[j + 3 * T * 64])) * rs + rgb[j];
        int grp = 0; float gm = gl[0];
#pragma unroll
        for (int j = 1; j < 4; ++j) if (gl[j] > gm) { gm = gl[j]; grp = j; }
        float gs = 0.f;
#pragma unroll
        for (int j = 0; j < 4; ++j) gs += __expf(gl[j] - gm);
        const float gw = 1.0f / gs;
        float el[8];
#pragma unroll
        for (int j = 0; j < 8; ++j) { const float* q_ = lp + 4 + grp * 8 + j; el[j] = ((q_[0] + q_[T * 64]) + (q_[2 * T * 64] + q_[3 * T * 64])) * rs + reb[grp * 8 + j]; }
        int i0 = 0; float m0 = el[0];
#pragma unroll
        for (int j = 1; j < 8; ++j) if (el[j] > m0) { m0 = el[j]; i0 = j; }
        int i1 = -1; float m1 = -3.0e38f;
#pragma unroll
        for (int j = 0; j < 8; ++j) if (j != i0 && el[j] > m1) { m1 = el[j]; i1 = j; }
        const float e1 = __expf(m1 - m0), w0 = gw / (1.0f + e1), w1 = gw * e1 / (1.0f + e1);
        const int ex0 = grp * 8 + i0, ex1 = grp * 8 + i1;
        const unsigned r0 = __hip_atomic_fetch_add(lc + ex0, 1u, __ATOMIC_RELAXED, __HIP_MEMORY_SCOPE_WORKGROUP), r1 = __hip_atomic_fetch_add(lc + ex1, 1u, __ATOMIC_RELAXED, __HIP_MEMORY_SCOPE_WORKGROUP);
        __syncthreads();
        if (tid < 32) { const unsigned n = lc[tid]; lc[32 + tid] = n ? atomicAdd(cnt + tid, n) : 0u; lc[tid] = 0u; }
        __syncthreads();
        const int p0 = (int)(lc[32 + ex0] + r0), p1 = (int)(lc[32 + ex1] + r1);
        __syncthreads();
        C.toke()[2 * t] = ex0; C.toke()[2 * t + 1] = ex1; C.tokp()[2 * t] = p0; C.tokp()[2 * t + 1] = p1; C.tokw()[2 * t] = w0; C.tokw()[2 * t + 1] = w1;
    }
}
__device__ __forceinline__ void phase_slots(const Ctx& C) {
    const int l = C.layer, tid = otid(); const unsigned* cnt = C.ctl() + CW_CNT + l * 64;
    LAS int* offs = (LAS int*)(C.lds + LDS_MISC);
    LAS int* cl = (LAS int*)(C.lds + LDS_MISC + 512);
    if (tid < 32) cl[tid] = (int)__hip_atomic_load(cnt + tid, __ATOMIC_RELAXED, __HIP_MEMORY_SCOPE_AGENT);
    __syncthreads();
    if (tid == 0) { int o = 0; for (int e = 0; e < 32; ++e) { offs[e] = o; o += (cl[e] + 255) >> 8; } offs[32] = o;
        if (C.c == 0) { for (int e = 0; e < 32; ++e) for (int r = offs[e]; r < offs[e + 1]; ++r) C.texp()[r] = e; C.ctl()[CW_NTILE + l] = (unsigned)o; } }
    __syncthreads();
    for (int i = C.c * NTHREADS + tid; i < 2 * T; i += C.G * NTHREADS) { const int e = C.toke()[i], slot = offs[e] * 256 + C.tokp()[i]; C.stok()[slot] = i >> 1; C.sdst()[slot] = i; C.sw()[slot] = C.tokw()[i]; }
    __syncthreads();
}

namespace at {
constexpr int SHM = 16384;
constexpr int L_V = 0, L_K = 32768, L_WS = 65536, L_TBL = L_WS + 2048, L_IMP = L_TBL + 2048, L_SELB = L_IMP + 16384, L_WUN = L_SELB + 512, L_TL = L_WUN + 64, L_OST = L_TL + 512  , L_END = L_OST + 8 * 4352;
static_assert(L_OST % 16 == 0 && L_END <= 131072, "attention LDS layout");
constexpr float C2 = 0.08838834764831845f * LOG2E;
#define KSWZ(row, colB) ((row) * 256 + ((colB) ^ (((row) & 7) << 4)))
__device__ __forceinline__ int v_st(int k, int c) { const int kk = (k & ~0xC) | ((k & 4) << 1) | ((k & 8) >> 1); return ((kk >> 3) * 4 + (c >> 5)) * 512 + ((kk & 7) * 32 + (c & 31)) * 2; }
__device__ __forceinline__ int v_rd_base(int lane) { return ((lane & 3) << 3) | (((lane >> 2) & 3) << 6) | (((lane >> 4) & 1) << 5) | (((lane >> 5) & 1) << 8); }
constexpr int v_rd_off(int d0, int ks, int half) { return d0 * 512 + ks * 4096 + half * 2048; }
__device__ __forceinline__ int t5_bucket(int n) {
    if (n < 16) return n;
    const int th[16] = {16, 19, 21, 24, 27, 31, 35, 40, 46, 52, 59, 67, 77, 87, 99, 113};
    int b = 16;
#pragma unroll
    for (int i = 1; i < 16; ++i) b += (n >= th[i]) ? 1 : 0;
    return b;
}
enum { M_CMP1 = 0, M_CMP2 = 1, M_SEL = 2, M_WIN = 3 };
struct St {
    bf16x8 qr[8]; f32x16 o[4]; float m, l, rl, bfar; int tq; unsigned mlo, mhi;
};
template <int KB>
__device__ __forceinline__ void qkt(f32x16& p0, f32x16& p1, const LAS char* K_lds, int r32, int hi, const bf16x8* qr) {
    p0 = f32x16{}; p1 = f32x16{};
    const LAS char* kb[4];
#pragma unroll
    for (int dd = 0; dd < 4; ++dd) kb[dd] = K_lds + KB * SHM + KSWZ(r32, (dd * 16 + hi * 8) * 2);
#pragma unroll
    for (int d0 = 0; d0 < 8; ++d0) { const LAS char* a = kb[d0 & 3] + (d0 >> 2) * 128;
        const bf16x8 b0 = *reinterpret_cast<const LAS bf16x8*>(a);
        const bf16x8 b1 = *reinterpret_cast<const LAS bf16x8*>(a + 32 * 256);
        p0 = __builtin_amdgcn_mfma_f32_32x32x16_bf16(b0, qr[d0], p0, 0, 0, 0);
        p1 = __builtin_amdgcn_mfma_f32_32x32x16_bf16(b1, qr[d0], p1, 0, 0, 0); }
}
template <int VB>
__device__ __forceinline__ void pv_tile(f32x16* o, int vb0, bf16x8 pa0, bf16x8 pa1, bf16x8 pa2, bf16x8 pa3) {
#define TRRD(dst, off) asm volatile("ds_read_b64_tr_b16 %0, %1 offset:%2" : "=&v"(dst) : "v"(vb0), "i"(off) : "memory")
#define PV_D0(d0) do { s16x4 l0, l1, l2, l3, h0, h1, h2, h3; constexpr int b_ = VB * SHM + v_rd_off(d0, 0, 0); \
        TRRD(l0, b_); TRRD(h0, b_ + 2048); TRRD(l1, b_ + 4096); TRRD(h1, b_ + 6144); TRRD(l2, b_ + 8192); TRRD(h2, b_ + 10240); TRRD(l3, b_ + 12288); TRRD(h3, b_ + 14336); \
        asm volatile("s_waitcnt lgkmcnt(0)" ::: "memory"); __builtin_amdgcn_sched_barrier(0); \
        o[d0] = __builtin_amdgcn_mfma_f32_32x32x16_bf16(pa0, (bf16x8){l0[0], l0[1], l0[2], l0[3], h0[0], h0[1], h0[2], h0[3]}, o[d0], 0, 0, 0); \
        o[d0] = __builtin_amdgcn_mfma_f32_32x32x16_bf16(pa1, (bf16x8){l1[0], l1[1], l1[2], l1[3], h1[0], h1[1], h1[2], h1[3]}, o[d0], 0, 0, 0); \
        o[d0] = __builtin_amdgcn_mfma_f32_32x32x16_bf16(pa2, (bf16x8){l2[0], l2[1], l2[2], l2[3], h2[0], h2[1], h2[2], h2[3]}, o[d0], 0, 0, 0); \
        o[d0] = __builtin_amdgcn_mfma_f32_32x32x16_bf16(pa3, (bf16x8){l3[0], l3[1], l3[2], l3[3], h3[0], h3[1], h3[2], h3[3]}, o[d0], 0, 0, 0); } while (0)
    PV_D0(0); PV_D0(1); PV_D0(2); PV_D0(3);
#undef PV_D0
#undef TRRD
}
__device__ __forceinline__ float swapmax(float v) { auto rr = __builtin_amdgcn_permlane32_swap(__float_as_uint(v), __float_as_uint(v), false, false); return fmaxf(__uint_as_float(rr[0]), __uint_as_float(rr[1])); }
__device__ __forceinline__ float swapsum(float v) { auto rr = __builtin_amdgcn_permlane32_swap(__float_as_uint(v), __float_as_uint(v), false, false); return __uint_as_float(rr[0]) + __uint_as_float(rr[1]); }
#define PK4(P, B_, OUT) do { const unsigned a0_ = cvtpk(P[B_ + 0], P[B_ + 1]), a1_ = cvtpk(P[B_ + 2], P[B_ + 3]), b0_ = cvtpk(P[B_ + 4], P[B_ + 5]), b1_ = cvtpk(P[B_ + 6], P[B_ + 7]); \
        auto r0_ = __builtin_amdgcn_permlane32_swap(a0_, b0_, false, false); auto r1_ = __builtin_amdgcn_permlane32_swap(a1_, b1_, false, false); \
        u32x4 w_ = {r0_[0], r1_[0], r0_[1], r1_[1]}; OUT = *reinterpret_cast<bf16x8*>(&w_); } while (0)

template <int MODE, int BUF>
__device__ __forceinline__ void tile_body(St& S, LAS char* L, int row0, int qb, int wid, int r32, int hi, int vb0) {
    const float NEG = -__builtin_inff();
    const int tl = r32 >> 2, hl = r32 & 3;
    f32x16 p0, p1;
    qkt<BUF>(p0, p1, L + L_K, r32, hi, S.qr);
    const LAS float* tb = (const LAS float*)(L + L_TBL) + hl * 128;
    bool fastp = false; float beff = 0.f;
    if constexpr (MODE == M_CMP1 || MODE == M_CMP2) {
        const int dq = S.tq - 31 - 16 * (row0 + 4 * hi);
        if (qb * 64 - 31 - 16 * (row0 + 63) >= 127) {
#pragma unroll
            for (int r = 0; r < 16; ++r) { p0[r] = fmaf(p0[r], C2, S.bfar); p1[r] = fmaf(p1[r], C2, S.bfar); }
        } else
#pragma unroll
        for (int r = 0; r < 16; ++r) { const int c = (r & 3) + 8 * (r >> 2);
            { const int d = dq - 16 * c; const int ix = d < 0 ? 0 : (d > 127 ? 127 : d); const float x = fmaf(p0[r], C2, tb[ix]); p0[r] = d >= 0 ? x : NEG; }
            { const int d = dq - 16 * (c + 32); const int ix = d < 0 ? 0 : (d > 127 ? 127 : d); const float x = fmaf(p1[r], C2, tb[ix]); p1[r] = d >= 0 ? x : NEG; } }
    } else {
        const int kpos0 = row0 & (SEQ - 1), j = kpos0 >> 6; const int dq = S.tq - kpos0 - 4 * hi;
        const bool near = j >= qb - 2;
        fastp = !near && !(MODE == M_WIN && j == qb - 8);
        if (MODE == M_SEL) { const bool sel_ = (j < 32 ? (S.mlo >> j) : (S.mhi >> (j - 32))) & 1u; beff = sel_ ? S.bfar : NEG; } else beff = S.bfar;
        if (fastp) { }
        else if (near) {
#pragma unroll
            for (int r = 0; r < 16; ++r) { const int c = (r & 3) + 8 * (r >> 2);
                { const int d = dq - c; const int ix = d < 0 ? 0 : (d > 127 ? 127 : d); p0[r] = fmaf(p0[r], C2, tb[ix]); }
                { const int d = dq - c - 32; const int ix = d < 0 ? 0 : (d > 127 ? 127 : d); p1[r] = fmaf(p1[r], C2, tb[ix]); } }
        } else {
#pragma unroll
            for (int r = 0; r < 16; ++r) { p0[r] = fmaf(p0[r], C2, S.bfar); p1[r] = fmaf(p1[r], C2, S.bfar); }
        }
        if constexpr (MODE == M_WIN) {
            if (j == qb || j == qb - 8) {
#pragma unroll
                for (int r = 0; r < 16; ++r) { const int c = (r & 3) + 8 * (r >> 2);
                    if ((unsigned)(dq - c) >= 512u) p0[r] = NEG;
                    if ((unsigned)(dq - c - 32) >= 512u) p1[r] = NEG; }
            }
        } else {
            const bool sel = (j < 32 ? (S.mlo >> j) : (S.mhi >> (j - 32))) & 1u;
            if (j == qb) {
#pragma unroll
                for (int r = 0; r < 16; ++r) { const int c = (r & 3) + 8 * (r >> 2);
                    if (dq - c < 0) p0[r] = NEG;
                    if (dq - c - 32 < 0) p1[r] = NEG; }
            }
            if (!sel && !fastp) {
#pragma unroll
                for (int r = 0; r < 16; ++r) { p0[r] = NEG; p1[r] = NEG; }
            }
        }
    }
    if constexpr (MODE == M_CMP1) {
        float pmax = p0[0];
#pragma unroll
        for (int r = 1; r < 16; ++r) pmax = fmaxf(pmax, p0[r]);
#pragma unroll
        for (int r = 0; r < 16; ++r) pmax = fmaxf(pmax, p1[r]);
        pmax = swapmax(pmax);
        const float mn = fmaxf(S.m, pmax), alpha = __builtin_amdgcn_exp2f(S.m - mn); S.m = mn;
        float ps = 0.f;
#pragma unroll
        for (int r = 0; r < 16; ++r) ps += __builtin_amdgcn_exp2f(p0[r] - mn) + __builtin_amdgcn_exp2f(p1[r] - mn);
        ps = swapsum(ps); S.l = S.l * alpha + ps;
    } else if constexpr (MODE == M_CMP2) {
#pragma unroll
        for (int r = 0; r < 16; ++r) { p0[r] = __builtin_amdgcn_exp2f(p0[r] - S.m) * S.rl; p1[r] = __builtin_amdgcn_exp2f(p1[r] - S.m) * S.rl; }
        LAS float* imp = (LAS float*)(L + L_IMP) + (wid * 8 + tl) * 64;
#pragma unroll
        for (int q = 0; q < 8; ++q) { const int rb = (q & 3) * 4; float s4, last;
            if (q < 4) { s4 = (p0[rb] + p0[rb + 1]) + (p0[rb + 2] + p0[rb + 3]); last = p0[rb + 3]; } else { s4 = (p1[rb] + p1[rb + 1]) + (p1[rb + 2] + p1[rb + 3]); last = p1[rb + 3]; }
            s4 += __shfl_xor(s4, 1); s4 += __shfl_xor(s4, 2); last += __shfl_xor(last, 1); last += __shfl_xor(last, 2);
            const int n = (row0 >> 2) + 2 * (q & 3) + hi + 8 * (q >> 2);
            if (hl == 0 && n < 64) { __hip_atomic_fetch_add(imp + n, s4, __ATOMIC_RELAXED, __HIP_MEMORY_SCOPE_WORKGROUP);
                if (n + 1 < 64) __hip_atomic_fetch_add(imp + n + 1, last, __ATOMIC_RELAXED, __HIP_MEMORY_SCOPE_WORKGROUP); } }
        bf16x8 pa0, pa1, pa2, pa3; PK4(p0, 0, pa0); PK4(p0, 8, pa1); PK4(p1, 0, pa2); PK4(p1, 8, pa3);
        pv_tile<BUF>(S.o, vb0, pa0, pa1, pa2, pa3);
    } else {
        float pmax = p0[0];
#pragma unroll
        for (int r = 1; r < 16; ++r) pmax = fmaxf(pmax, p0[r]);
#pragma unroll
        for (int r = 0; r < 16; ++r) pmax = fmaxf(pmax, p1[r]);
        pmax = swapmax(pmax);
        if (fastp) pmax = fmaf(pmax, C2, beff);
        float mn, alpha;
        if (__all(pmax - S.m <= 11.5f)) { mn = S.m; alpha = 1.f; }
        else { mn = fmaxf(S.m, pmax); alpha = __builtin_amdgcn_exp2f(S.m - mn); S.m = mn; }
        float ps = 0.f;
        if (fastp) { const float off = beff - mn;
#pragma unroll
            for (int r = 0; r < 16; ++r) { p0[r] = __builtin_amdgcn_exp2f(fmaf(p0[r], C2, off)); p1[r] = __builtin_amdgcn_exp2f(fmaf(p1[r], C2, off)); ps += p0[r] + p1[r]; }
        } else {
#pragma unroll
            for (int r = 0; r < 16; ++r) { p0[r] = __builtin_amdgcn_exp2f(p0[r] - mn); p1[r] = __builtin_amdgcn_exp2f(p1[r] - mn); ps += p0[r] + p1[r]; }
        }
        ps = swapsum(ps); S.l = S.l * alpha + ps;
        bf16x8 pa0, pa1, pa2, pa3; PK4(p0, 0, pa0); PK4(p0, 8, pa1); PK4(p1, 0, pa2); PK4(p1, 8, pa3);
        if (__any(alpha < 1.f)) {
            LAS float* al = (LAS float*)(L + L_WS) + wid * 64;
            if (hi == 0) al[r32] = alpha;
            asm volatile("s_waitcnt lgkmcnt(0)" ::: "memory");
#pragma unroll
            for (int g4 = 0; g4 < 4; ++g4) { const f32x4 a = *(const LAS f32x4*)(al + 8 * g4 + 4 * hi);
#pragma unroll
                for (int d = 0; d < 4; ++d) { S.o[d][4 * g4] *= a[0]; S.o[d][4 * g4 + 1] *= a[1]; S.o[d][4 * g4 + 2] *= a[2]; S.o[d][4 * g4 + 3] *= a[3]; } }
        }
        pv_tile<BUF>(S.o, vb0, pa0, pa1, pa2, pa3);
    }
}
struct RowSeq { int base, step; const LAS int* list; };
__device__ __forceinline__ int row_of(const RowSeq& q, int i) { return q.list ? __builtin_amdgcn_readfirstlane(q.list[i]) : q.base + q.step * i; }
template <int MODE>
__device__ __forceinline__ void attn_loop(St& S, LAS char* L, int n, const RowSeq& seq, const bf16_t* Kp, const bf16_t* Vp, int ld, int qb) {
    const int tid = otid(), wid = __builtin_amdgcn_readfirstlane(tid >> 6), lane = tid & 63, r32 = lane & 31, hi = lane >> 5;
    const int sr = tid >> 4, sc = (tid & 15) * 8, kws = KSWZ(sr, sc * 2), vst0 = v_st(sr, sc), vst1 = v_st(32 + sr, sc);
    const int vb0 = (int)(size_t)(L + L_V) + v_rd_base(lane);
    bf16x8 st_k0, st_k1, st_v0, st_v1;
#define AT_LOAD(r0) do { const size_t o_ = (size_t)((r0) + sr) * ld + sc; st_k0 = *(const bf16x8*)(Kp + o_); st_k1 = *(const bf16x8*)(Kp + o_ + (size_t)32 * ld); st_v0 = *(const bf16x8*)(Vp + o_); st_v1 = *(const bf16x8*)(Vp + o_ + (size_t)32 * ld); } while (0)
#define AT_WRITE(bf) do { *(LAS bf16x8*)(L + L_K + (bf) * SHM + kws) = st_k0; *(LAS bf16x8*)(L + L_K + (bf) * SHM + kws + 32 * 256) = st_k1; \
                          *(LAS bf16x8*)(L + L_V + (bf) * SHM + vst0) = st_v0; *(LAS bf16x8*)(L + L_V + (bf) * SHM + vst1) = st_v1; } while (0)
    if (n <= 0) return;
    AT_LOAD(row_of(seq, 0)); AT_WRITE(0); if (n > 1) AT_LOAD(row_of(seq, 1));
    __syncthreads();
    for (int i = 0; i < n; i += 2) {
        tile_body<MODE, 0>(S, L, row_of(seq, i), qb, wid, r32, hi, vb0);
        if (i + 1 < n) { AT_WRITE(1); if (i + 2 < n) AT_LOAD(row_of(seq, i + 2)); }
        __syncthreads();
        if (i + 1 < n) {
            tile_body<MODE, 1>(S, L, row_of(seq, i + 1), qb, wid, r32, hi, vb0);
            if (i + 2 < n) { AT_WRITE(0); if (i + 3 < n) AT_LOAD(row_of(seq, i + 3)); }
            __syncthreads();
        }
    }
#undef AT_LOAD
#undef AT_WRITE
}
template <int SM>
__device__ __forceinline__ void store_o(const St& S, LAS char* L, float fac, bf16_t* obase  , int wid, int r32, int hi, unsigned char* obase8 = nullptr) {
    constexpr bool ACCUM = SM != 0;
    LAS float* fl = (LAS float*)(L + L_WS) + wid * 64 + 32;
    if (hi == 0) fl[r32] = fac;
    asm volatile("s_waitcnt lgkmcnt(0)" ::: "memory");
    const bool ev = (r32 & 1) == 0;
    LAS bf16_t* stg = (LAS bf16_t*)(L + L_OST) + wid * (16 * 136);
    const int lane = hi * 32 + r32, rq = lane >> 4, ch = (lane & 15) * 8;
#pragma unroll
    for (int h2 = 0; h2 < 2; ++h2) {
#pragma unroll
        for (int gg = 0; gg < 2; ++gg) { const int g4 = 2 * h2 + gg; const f32x4 f = *(const LAS f32x4*)(fl + 8 * g4 + 4 * hi);
#pragma unroll
            for (int jj = 0; jj < 4; ++jj)
#pragma unroll
                for (int d0 = 0; d0 < 4; ++d0) { const float v = S.o[d0][4 * g4 + jj] * f[jj]; const float vn = __shfl_xor(v, 1);
                    if (ev) *(LAS unsigned*)(stg + (gg * 8 + 4 * hi + jj) * 136 + d0 * 32 + r32) = cvtpk(v, vn); } }
        asm volatile("s_waitcnt lgkmcnt(0)" ::: "memory");
        u32x4 nv[4], ov[4];
#pragma unroll
        for (int it = 0; it < 4; ++it) { const int rowl = it * 4 + rq, row = h2 * 16 + rowl;
            nv[it] = *(const LAS u32x4*)(stg + rowl * 136 + ch);
            if (ACCUM) ov[it] = *(const u32x4*)(obase + (size_t)(row >> 2) * 3072 + (row & 3) * 128 + ch); }
#pragma unroll
        for (int it = 0; it < 4; ++it) { const int row = h2 * 16 + it * 4 + rq; const u32x4 n = nv[it];
            f32x4 a = (f32x4){bflo(n.x), bfhi(n.x), bflo(n.y), bfhi(n.y)}, c = (f32x4){bflo(n.z), bfhi(n.z), bflo(n.w), bfhi(n.w)};
            if (ACCUM) { const u32x4 o = ov[it]; a += (f32x4){bflo(o.x), bfhi(o.x), bflo(o.y), bfhi(o.y)}; c += (f32x4){bflo(o.z), bfhi(o.z), bflo(o.w), bfhi(o.w)}; }
            if (SM == 2) { u32x2 w; w.x = pk4_fp8(a[0] * 16.f, a[1] * 16.f, a[2] * 16.f, a[3] * 16.f); w.y = pk4_fp8(c[0] * 16.f, c[1] * 16.f, c[2] * 16.f, c[3] * 16.f);
                *(u32x2*)(obase8 + (size_t)(row >> 2) * 6144 + (row & 3) * 128 + ch) = w; }
            else if (ACCUM) *(u32x4*)(obase + (size_t)(row >> 2) * 3072 + (row & 3) * 128 + ch) = pack8f(a, c);
            else *(u32x4*)(obase + (size_t)(row >> 2) * 3072 + (row & 3) * 128 + ch) = n; }
        asm volatile("" ::: "memory"); }
}
template <bool FIRST>
__device__ __forceinline__ void acc_o(const St& S, LAS char* L, float fac, unsigned (&tot)[16], int wid, int r32, int hi) {
    LAS float* fl = (LAS float*)(L + L_WS) + wid * 64 + 32;
    LAS unsigned* tl_ = (LAS unsigned*)(L + L_OST + wid * 4352) + (hi * 32 + r32);
    if (hi == 0) fl[r32] = fac;
    asm volatile("s_waitcnt lgkmcnt(0)" ::: "memory");
#pragma unroll
    for (int g4 = 0; g4 < 4; ++g4) { const f32x4 f = *(const LAS f32x4*)(fl + 8 * g4 + 4 * hi);
#pragma unroll
        for (int d0 = 0; d0 < 4; ++d0)
#pragma unroll
            for (int jp = 0; jp < 2; ++jp) { float a = S.o[d0][4 * g4 + 2 * jp] * f[2 * jp], c = S.o[d0][4 * g4 + 2 * jp + 1] * f[2 * jp + 1]; const int k = d0 * 4 + (g4 & 1) * 2 + jp;
                if (g4 < 2) { if (!FIRST) { a += bflo(tot[k]); c += bfhi(tot[k]); } tot[k] = cvtpk(a, c); }
                else { if (!FIRST) { const unsigned t = tl_[k * 64]; a += bflo(t); c += bfhi(t); } tl_[k * 64] = cvtpk(a, c); } } }
    asm volatile("" ::: "memory");
}
__device__ __forceinline__ void store_tot(const unsigned (&tot)[16], LAS char* L, unsigned char* obase8, int wid, int r32, int hi) {
    const bool ev = (r32 & 1) == 0;
    LAS bf16_t* stg = (LAS bf16_t*)(L + L_OST) + wid * (16 * 136);
    const LAS unsigned* tl_ = (const LAS unsigned*)(L + L_OST + wid * 4352) + (hi * 32 + r32);
    unsigned thi[16];
#pragma unroll
    for (int k = 0; k < 16; ++k) thi[k] = tl_[k * 64];
    asm volatile("s_waitcnt lgkmcnt(0)" ::: "memory");
    const int lane = otid() & 63, rq = lane >> 4, ch = (lane & 15) * 8;
#pragma unroll
    for (int h2 = 0; h2 < 2; ++h2) {
#pragma unroll
        for (int gg = 0; gg < 2; ++gg)
#pragma unroll
            for (int jj = 0; jj < 4; ++jj)
#pragma unroll
                for (int d0 = 0; d0 < 4; ++d0) { const int k = d0 * 4 + gg * 2 + (jj >> 1); const unsigned t = h2 ? thi[k] : tot[k]; const float v = (jj & 1) ? bfhi(t) : bflo(t); const float vn = __shfl_xor(v, 1);
                    if (ev) *(LAS unsigned*)(stg + (gg * 8 + 4 * hi + jj) * 136 + d0 * 32 + r32) = cvtpk(v, vn); }
        asm volatile("s_waitcnt lgkmcnt(0)" ::: "memory");
#pragma unroll
        for (int it = 0; it < 4; ++it) { const int rowl = it * 4 + rq, row = h2 * 16 + rowl; const u32x4 n = *(const LAS u32x4*)(stg + rowl * 136 + ch);
            u32x2 w; w.x = pk4_fp8(bflo(n.x) * 16.f, bfhi(n.x) * 16.f, bflo(n.y) * 16.f, bfhi(n.y) * 16.f); w.y = pk4_fp8(bflo(n.z) * 16.f, bfhi(n.z) * 16.f, bflo(n.w) * 16.f, bfhi(n.w) * 16.f);
            *(u32x2*)(obase8 + (size_t)(row >> 2) * 6144 + (row & 3) * 128 + ch) = w; }
        asm volatile("s_waitcnt lgkmcnt(0)" ::: "memory"); }
}
__device__ __forceinline__ void attn_unit(const Ctx& C, int b, int g, int qb) {

    const int tid = otid(), wid = __builtin_amdgcn_readfirstlane(tid >> 6), lane = tid & 63, r32 = lane & 31, hi = lane >> 5, tl = r32 >> 2, hl = r32 & 3;
    LAS char* L = (LAS char*)(C.lds + LDS_STAGE);
    const int t0 = qb * 64, tokl = wid * 8 + tl, bg = b * 2 + g;
    St S; S.tq = t0 + tokl;
    const size_t trow = (size_t)b * SEQ + S.tq; const int head = g * 4 + hl;
    { const int h = tid >> 7, i = tid & 127; ((LAS float*)(L + L_TBL))[tid] = C.in(I_REL)[t5_bucket(i) * 8 + g * 4 + h] * LOG2E; }
    for (int i = tid; i < 4096; i += NTHREADS) ((LAS float*)(L + L_IMP))[i] = 0.f;
    { const bf16_t* qp = C.Z() + trow * LDZ + ZQ + head * 128 + hi * 8;
#pragma unroll
      for (int d0 = 0; d0 < 8; ++d0) S.qr[d0] = *(const bf16x8*)(qp + d0 * 16); }
    const bf16_t* gp = C.Z() + trow * LDZ + ZG24 + head * 3;
    const float g_cmp = bf2f(gp[0]), g_sel = bf2f(gp[1]), g_win = bf2f(gp[2]);
    S.bfar = C.in(I_REL)[31 * 8 + head] * LOG2E;
    unsigned tot[16];
    __syncthreads();
    const int ntc = (4 * qb + 2) / 64 + 1;
    { RowSeq q{0, 64, nullptr}; const bf16_t* Kc = C.KCMP() + (size_t)bg * 256 * 128; const bf16_t* Vc = C.VCMP() + (size_t)bg * 256 * 128;
      S.m = -1e30f; S.l = 0.f;
      attn_loop<M_CMP1>(S, L, ntc, q, Kc, Vc, 128, qb);
      S.rl = S.l > 0.f ? 1.0f / S.l : 0.f;
#pragma unroll
      for (int d = 0; d < 4; ++d) S.o[d] = f32x16{};
      attn_loop<M_CMP2>(S, L, ntc, q, Kc, Vc, 128, qb);
      acc_o<true>(S, L, g_cmp, tot, wid, r32, hi); }
    __syncthreads();
    { const int tk = tid >> 3, sub = tid & 7; const LAS unsigned* ip = (const LAS unsigned*)(L + L_IMP) + tk * 64; unsigned byte = 0;
      if (qb < 16) { const int nv = qb + 1 - sub * 8; byte = nv >= 8 ? 0xffu : (nv > 0 ? (1u << nv) - 1u : 0u); }
      else { unsigned sc[64];
#pragma unroll
        for (int q4 = 0; q4 < 16; ++q4) { const u32x4 v = *(const LAS u32x4*)(ip + q4 * 4); sc[q4 * 4] = v.x; sc[q4 * 4 + 1] = v.y; sc[q4 * 4 + 2] = v.z; sc[q4 * 4 + 3] = v.w; }
#pragma unroll
        for (int n = 0; n < 64; ++n) { const unsigned key = ((sc[n] & ~63u) | (unsigned)(63 - n)) + 64u; sc[n] = (n == 0 || n == qb || n == qb - 1) ? (0xffffff00u | (unsigned)(63 - n)) : (n <= qb ? key : 0u); }
        for (int i = 0; i < 8; ++i) { const int n = sub * 8 + i; unsigned v = ip[n]; v = ((v & ~63u) | (unsigned)(63 - n)) + 64u; v = (n == 0 || n == qb || n == qb - 1) ? (0xffffff00u | (unsigned)(63 - n)) : v; int rank = 0;
#pragma unroll
            for (int k = 0; k < 64; ++k) rank += sc[k] > v ? 1 : 0;
            if (rank < 16 && n <= qb) byte |= 1u << i; } }
      ((LAS unsigned char*)(L + L_SELB))[tk * 8 + sub] = (unsigned char)byte; }
    __syncthreads();
    { const LAS unsigned* mp = (const LAS unsigned*)(L + L_SELB) + tokl * 2; S.mlo = mp[0]; S.mhi = mp[1];
      unsigned ulo = S.mlo, uhi = S.mhi;
#pragma unroll
      for (int o = 32; o >= 1; o >>= 1) { ulo |= __shfl_xor(ulo, o); uhi |= __shfl_xor(uhi, o); }
      if (lane == 0) { ((LAS unsigned*)(L + L_WUN))[wid * 2] = ulo; ((LAS unsigned*)(L + L_WUN))[wid * 2 + 1] = uhi; } }
    __syncthreads();
    if (tid == 0) { unsigned ulo = 0, uhi = 0; for (int w = 0; w < 8; ++w) { ulo |= ((LAS unsigned*)(L + L_WUN))[w * 2]; uhi |= ((LAS unsigned*)(L + L_WUN))[w * 2 + 1]; }
        LAS int* tlst = (LAS int*)(L + L_TL); int n = 0;
        for (int j = 0; j < 64; ++j) { const unsigned bit = j < 32 ? (ulo >> j) & 1u : (uhi >> (j - 32)) & 1u; if (bit) tlst[1 + n++] = b * SEQ + 64 * j; }
        tlst[0] = n; }
    __syncthreads();
    { LAS int* tlst = (LAS int*)(L + L_TL); const int nsel = __builtin_amdgcn_readfirstlane(tlst[0]); RowSeq q{0, 0, tlst + 1};
      const bf16_t* Ks = C.Z() + ZKV + 512 + g * 128; const bf16_t* Vs = C.Z() + ZKV + 768 + g * 128;
      S.m = -1e30f; S.l = 0.f;
#pragma unroll
      for (int d = 0; d < 4; ++d) S.o[d] = f32x16{};
      attn_loop<M_SEL>(S, L, nsel, q, Ks, Vs, LDZ, qb);
      acc_o<false>(S, L, S.l > 0.f ? g_sel / S.l : 0.f, tot, wid, r32, hi); }
    { const int jlo = qb > 8 ? qb - 8 : 0; RowSeq q{b * SEQ + 64 * jlo, 64, nullptr};
      const bf16_t* Kw = C.Z() + ZKV + 1024 + g * 128; const bf16_t* Vw = C.Z() + ZKV + 1280 + g * 128;
      S.m = -1e30f; S.l = 0.f;
#pragma unroll
      for (int d = 0; d < 4; ++d) S.o[d] = f32x16{};
      attn_loop<M_WIN>(S, L, qb - jlo + 1, q, Kw, Vw, LDZ, qb);
      acc_o<false>(S, L, S.l > 0.f ? g_win / S.l : 0.f, tot, wid, r32, hi);
      store_tot(tot, L, (unsigned char*)C.OB() + ((size_t)b * SEQ + t0 + wid * 8) * 6144 + 3072 + (size_t)g * 512, wid, r32, hi); }
    __syncthreads();
}
__device__ __forceinline__ void phase_attn(const Ctx& C) {
    for (int it = C.c; it < 256; it += C.G) { const int bg = it & 7, x = it >> 3;
#pragma unroll 1
        for (int hf = 0; hf < 2; ++hf) attn_unit(C, bg >> 1, bg & 1, hf ? 63 - x : x); }
}
}

constexpr int NPH_LAYER = 16, NPH = 2 * NPH_LAYER + 1;
__global__ void __launch_bounds__(NTHREADS, 2) fwd(Params P) {
    extern __shared__ __attribute__((aligned(16))) unsigned char lds_raw[];
    LAS unsigned char* lds = (LAS unsigned char*)lds_raw;
    Ctx C; C.p = launder_kp(); C.G = gridDim.x; C.c = blockIdx.x; C.lds = lds; C.layer = 0;
    C.ws = P.ws;
    C.x = (float*)launder((unsigned char*)P.out);
    volatile LAS unsigned* bst = (volatile LAS unsigned*)(lds + LDS_MISC + 1024);
    if (threadIdx.x < 4) bst[threadIdx.x] = 0u;
    __syncthreads();
    XcdBarrier bar; bar.bar = (unsigned*)(P.ws + WS_CTL) + CW_BAR; bar.x = 0; bar.st = bst;
    if (P.use_bar) bar = xcd_barrier_post((unsigned*)(P.ws + WS_CTL) + CW_BAR, bst);
    const int lo = P.ph_lo, hi = P.ph_hi;
#ifndef PHMASK
#define PHMASK 0x1ffff
#endif
#define RUN(k) (((PHMASK >> (k)) & 1) && runp(lo, hi, base + (k)))
#define SEAM(k) do { if (runp(lo, hi - 1, base + (k))) xcd_barrier(bar); } while (0)
#ifndef PROBE_NOEPI
#define PROBE_NOEPI 0
#endif
#ifndef PROBE_REP
#define PROBE_REP 0
#endif
#define REP(k) for (int rep_ = 0; rep_ < ((((PROBE_REP) >> (k)) & 1) && layer == 0 ? 2 : 1); ++rep_)
    for (int layer = 0; layer < NLAYER; ++layer) {
        const int base = layer * NPH_LAYER; C.layer = layer;

        REP(0) { if (RUN(0)) { PHASE_ENTER(); phase_prologue(C); }
        SEAM(0); }
        REP(1) { if (RUN(1)) { PHASE_ENTER();
            if (C.c == 0) { for (int i = threadIdx.x; i < 1024; i += NTHREADS) { const int kv = i >> 9, n = i & 511; float s = 0.f; for (int kc = 0; kc < 64; ++kc) s += C.b1p()[(kv * 64 + kc) * 512 + n]; C.b1()[i] = s; } }
            if (layer == 0) phase_rmsnorm<3, false>(C, C.in(I_X), C.in(I_ANORM) + layer * D, C.H(), C.H8()); else phase_rmsnorm<3, true>(C, C.XR(), C.in(I_ANORM) + layer * D, C.H(), C.H8());
        }
        SEAM(1); }
        REP(2) { if (RUN(2)) { PHASE_ENTER();
            { ProbInT<false> q; q.A = C.H(); q.Bt = C.Win() + (size_t)ZCONF * 2048; q.lda = 2048; q.ldb_ = 2048; q.nM = 64; q.nN = 17; q.ntk = 32; q.G = C.G; q.c = C.c; q.O = C.Z() + ZCONF; q.ldo = LDZ; q.O2 = q.O; q.ldo2 = LDZ; q.n1 = 64; pg8::gemm_phase(C.lds + LDS_STAGE, q); }
            { ProbInT<true> q; q.A = (const bf16_t*)C.H8(); q.Bt = (const bf16_t*)C.Wmg(); q.lda = 1024; q.ldb_ = 1024; q.nM = 64; q.nN = 38; q.ntk = 16; q.G = C.G; q.c = C.c; q.O = C.GB(); q.ldo = LDG; q.O2 = C.Z(); q.ldo2 = LDZ; q.n1 = LDG / 256; pg8::gemm_phase(C.lds + LDS_STAGE, q); } }
        SEAM(2); }
        REP(3) { if (RUN(3)) { PHASE_ENTER();
            phase_conv(C);
            ProbC1 q; q.Z = C.Z(); q.Wc1 = C.Wc1(); q.slab = (float*)C.MRG(); q.c = C.c; pg8::gemm_phase(C.lds + LDS_STAGE, q);
        }
        SEAM(3); }
        REP(4) { if (RUN(4)) { PHASE_ENTER(); phase_c1_reduce(C, (const float*)C.MRG()); if (C.p->use_bar) xcd_barrier(bar); PHASE_ENTER(); ProbC2 q; q.A = C.HID(); q.Bt = C.Wc2(); q.lda = 512; q.ldb_ = 512; q.nM = 16; q.nN = 1; q.ntk = 8; q.G = C.G; q.c = C.c; q.KC = C.KCMP(); q.VC = C.VCMP(); pg8::gemm_phase(C.lds + LDS_STAGE, q); }
        SEAM(4); }
        REP(5) { if (RUN(5)) { PHASE_ENTER(); at::phase_attn(C); }
        SEAM(5); }
        REP(6) { if (RUN(6)) { PHASE_ENTER();
            { ProbBr<false> q; q.OB = C.OB(); q.Wbr = C.Wbr(); q.Z = C.GB(); q.MRG = C.MRG(); q.G = C.G; q.c = C.c; pg8::gemm_phase(C.lds + LDS_STAGE, q); }
            { ProbBr<true> q; q.OB = C.OB(); q.Wbr = C.Wbr(); q.Z = C.GB(); q.MRG = C.MRG(); q.G = C.G; q.c = C.c; pg8::gemm_phase(C.lds + LDS_STAGE, q); } }
        SEAM(6); }
        REP(7) { if (RUN(7)) { PHASE_ENTER();
            if (layer == 0) { ProbOut<false> q; q.A = C.MRG(); q.Bt = C.Wout(); q.lda = 2048; q.ldb_ = 2048; q.nM = 64; q.nN = 8; q.ntk = 32; q.G = C.G; q.c = C.c; q.xin = C.in(I_X); q.xout = C.XR(); pg8::gemm_phase(C.lds + LDS_STAGE, q); }
            else { ProbOut<true> q; q.A = C.MRG(); q.Bt = C.Wout(); q.lda = 2048; q.ldb_ = 2048; q.nM = 64; q.nN = 8; q.ntk = 32; q.G = C.G; q.c = C.c; q.xin = C.XR(); q.xout = C.XR(); pg8::gemm_phase(C.lds + LDS_STAGE, q); } }
        SEAM(7); }
        REP(8) { if (RUN(8)) { PHASE_ENTER(); phase_rmsnorm<2, true>(C, C.XR(), C.in(I_FNORM) + layer * D, C.H(), C.H8(), C.RS()); }
        SEAM(8); }
        REP(9) { if (RUN(9)) { PHASE_ENTER(); ProbRt q; q.A = C.XR(); q.Bt = C.Wr(); q.lda = 2048; q.ldb_ = 2048; q.nM = 64; q.nN = 1; q.ntk = 8; q.G = C.G; q.c = C.c; q.LOG = C.LOG(); pg8::gemm_phase(C.lds + LDS_STAGE, q); }
        SEAM(9); }
        REP(10) { if (RUN(10)) { PHASE_ENTER(); phase_route(C); }
        SEAM(10); }
        REP(11) { if (RUN(11)) { PHASE_ENTER(); phase_slots(C); }
        SEAM(11); }
        REP(12) { if (RUN(12)) { PHASE_ENTER(); ProbUp q; q.H8 = C.H8(); q.Wgu = (const unsigned char*)C.Wgu(); q.HE = (unsigned char*)C.HE(); q.stok = C.stok(); q.texp = C.texp(); q.ntile = __builtin_amdgcn_readfirstlane((int)C.ctl()[CW_NTILE + layer]); q.G = C.G; q.c = C.c; pg8::gemm_phase(C.lds + LDS_STAGE, q); }
        SEAM(12); }
        REP(13) { if (RUN(13)) { PHASE_ENTER(); ProbDn q; q.HE = (const unsigned char*)C.HE(); q.Wd = (const unsigned char*)C.Wd(); q.YB = C.YB(); q.sdst = C.sdst(); q.sw = C.sw(); q.texp = C.texp(); q.ntile = __builtin_amdgcn_readfirstlane((int)C.ctl()[CW_NTILE + layer]); q.G = C.G; q.c = C.c; pg8::gemm_phase(C.lds + LDS_STAGE, q); }
        SEAM(13); }
        REP(14) { if (RUN(14)) { PHASE_ENTER(); phase_combine_norm(C, C.in(I_PNORM) + layer * D); }
        SEAM(14); }
        REP(15) { if (RUN(15)) { PHASE_ENTER();
            { ProbPp q; q.A = C.PB(); q.Bt = C.Wpp(); q.lda = 256; q.ldb_ = 256; q.nM = 64; q.nN = 8; q.ntk = 4; q.G = C.G; q.c = C.c; q.PP = C.PP(); pg8::gemm_phase(C.lds + LDS_STAGE, q); }
            __syncthreads();
            { ProbPg q; q.A = (const bf16_t*)C.H8(); q.Bt = C.Wpg(); q.lda = 1024; q.ldb_ = 1024; q.nM = 64; q.nN = 8; q.ntk = 16; q.G = C.G; q.c = C.c; q.PP = C.PP(); q.x = C.XR(); pg8::gemm_phase(C.lds + LDS_STAGE, q); }
        }
        SEAM(15); }
    }
    { const int base = 2 * NPH_LAYER; if (RUN(0)) { PHASE_ENTER(); phase_final_norm(C, C.in(I_FINAL)); } }
#undef RUN
#undef SEAM
}

#ifndef N_LAUNCH_MODE
#define N_LAUNCH_MODE 1
#endif
extern "C" void kernel_launch(void* const* d_in, const int* in_sizes, int n_in, void* d_out, int out_size, void* d_ws, size_t ws_size, hipStream_t stream) {
    static int grid = 0;
    if (grid == 0) {
        if (n_in != 27 || in_sizes[0] != T * D || out_size != T * D || ws_size < WS_END) {
            fprintf(stderr, "kernel_launch: unexpected problem (n_in %d, in0 %d, out %d, ws %zu, need %zu)\n", n_in, n_in > 0 ? in_sizes[0] : -1, out_size, ws_size, (size_t)WS_END); grid = -1; return; }
        int dev = 0, cus = 0, per_cu = 0;
        if (hipGetDevice(&dev) != hipSuccess || hipDeviceGetAttribute(&cus, hipDeviceAttributeMultiprocessorCount, dev) != hipSuccess) { grid = -1; return; }
        if (hipFuncSetAttribute((const void*)fwd, hipFuncAttributeMaxDynamicSharedMemorySize, LDS_BYTES) != hipSuccess) { fprintf(stderr, "kernel_launch: hipFuncSetAttribute failed\n"); grid = -1; return; }
        if (hipOccupancyMaxActiveBlocksPerMultiprocessor(&per_cu, (const void*)fwd, NTHREADS, LDS_BYTES) != hipSuccess || per_cu < 1) fprintf(stderr, "kernel_launch: occupancy query reports %d\n", per_cu);
        (void)hipGetLastError();
        grid = cus;
    }
    if (grid < 0) return;
    (void)hipMemsetAsync((char*)d_ws + WS_CTL, 0, CTL_BYTES, stream);
    Params p{};
    for (int i = 0; i < 27; ++i) p.in[i] = (const float*)d_in[i];
    p.out = (float*)d_out; p.ws = (unsigned char*)d_ws;
#if N_LAUNCH_MODE == 1
    p.ph_lo = 0; p.ph_hi = NPH; p.use_bar = 1;
    hipLaunchKernelGGL(fwd, dim3(grid), dim3(NTHREADS), LDS_BYTES, stream, p);
#else
    for (int ph = 0; ph < NPH; ++ph) { p.ph_lo = ph; p.ph_hi = ph + 1; p.use_bar = 0; hipLaunchKernelGGL(fwd, dim3(grid), dim3(NTHREADS), LDS_BYTES, stream, p); }
#endif
}
```
